# Optimizing an MI355X kernel written in HIP

```python
import jax, jax.numpy as jnp
from jax import lax
import numpy as np

D_MODEL = 1024
BATCH = 4
SEQ = 4096
DEPTH = 4
DEC_BATCH = 32
DEC_SEQ = 8
PAST_LEN = 8192
PAGE_SIZE = 128

N_A_LAYERS = DEPTH // 2
N_B_LAYERS = DEPTH - N_A_LAYERS
POOL_WINDOWS = (2, 4, 8, 16)
N_POOL_GROUPS = len(POOL_WINDOWS)
POOL_GROUP = D_MODEL // N_POOL_GROUPS
POOL_HIST = max(POOL_WINDOWS) - 1
WINDOWS = (128, 512, 2048)
DILATIONS = (1, 4, 16)
N_BRANCH = len(WINDOWS)
HEAD_DIM = 64
N_HEADS = D_MODEL // HEAD_DIM
ATTN_WIDTH = N_HEADS * HEAD_DIM
D_FF = -(-8 * D_MODEL // (3 * 256)) * 256
ROPE_THETA = 10000.0
EPS = 1e-6

kernel_name = "yoco_pool_dilated_swa_step"

F32 = jnp.float32


def _rmsnorm(x, g):
    xf = x.astype(F32)
    y = xf * lax.rsqrt(jnp.mean(xf * xf, axis=-1, keepdims=True) + EPS)
    return (y * g.astype(F32)).astype(x.dtype)


def _rope_tables(pos):
    inv = jnp.power(ROPE_THETA, -jnp.arange(0, HEAD_DIM, 2, dtype=F32) / HEAD_DIM)
    ang = pos.astype(F32)[:, None] * inv[None, :]
    ang = jnp.concatenate([ang, ang], axis=-1)
    return jnp.cos(ang), jnp.sin(ang)


def _rope(x, cos, sin):
    xf = x.astype(F32)
    x1, x2 = jnp.split(xf, 2, axis=-1)
    rot = jnp.concatenate([-x2, x1], axis=-1)
    c = cos[None, :, None, None, :]
    s = sin[None, :, None, None, :]
    return (xf * c + rot * s).astype(x.dtype)


def _swiglu(h, w_gate, w_up, w_down):
    return (jax.nn.silu(h @ w_gate) * (h @ w_up)) @ w_down


def _pool_mixer(u_ext, offset, w_pool, scale):
    L = u_ext.shape[1]
    idx = jnp.arange(offset, L)
    c = jnp.pad(jnp.cumsum(u_ext.astype(F32), axis=1), ((0, 0), (1, 0), (0, 0)))
    hi = c[:, offset + 1:]
    u = u_ext[:, offset:].astype(F32)
    outs = []
    for g, win in enumerate(POOL_WINDOWS):
        sl = slice(g * POOL_GROUP, (g + 1) * POOL_GROUP)
        lo = jnp.take(c[:, :, sl], jnp.maximum(idx + 1 - win, 0), axis=1)
        cnt = jnp.minimum(idx + 1, win).astype(F32)[None, :, None]
        d = (hi[:, :, sl] - lo) / cnt - u[:, :, sl]
        outs.append(d.astype(u_ext.dtype) @ w_pool[g])
    return jnp.concatenate(outs, axis=-1) * scale


def _shared_kv(x, kv_norm, w_kv, k_norm, cos, sin):
    B, S, _ = x.shape
    kv = (_rmsnorm(x, kv_norm) @ w_kv).reshape(B, S, 2, N_BRANCH, N_HEADS, HEAD_DIM)
    k = _rope(_rmsnorm(kv[:, :, 0], k_norm[:, None, :]), cos, sin)
    return k, kv[:, :, 1]


def _queries(x, b_norm, w_q, q_norm, cos, sin):
    B, S, _ = x.shape
    q = (_rmsnorm(x, b_norm) @ w_q).reshape(B, S, N_BRANCH, N_HEADS, HEAD_DIM)
    return _rope(_rmsnorm(q, q_norm[:, None, :]), cos, sin)


def _dilated_prompt(q, k, v, window, dil):
    B, S, H, D = q.shape
    blk = window // dil
    L = S // dil
    nb = -(-L // blk)
    Lp = nb * blk

    def to_blocks(a):
        a = a.reshape(B, L, dil, H, D).transpose(0, 2, 1, 3, 4)
        a = jnp.pad(a, ((0, 0), (0, 0), (0, Lp - L), (0, 0), (0, 0)))
        return a.reshape(B, dil, nb, blk, H, D)

    def with_prev(a):
        prev = jnp.pad(a, ((0, 0), (0, 0), (1, 0), (0, 0), (0, 0), (0, 0)))[:, :, :-1]
        return jnp.concatenate([prev, a], axis=3)

    qb = to_blocks(q)
    kc = with_prev(to_blocks(k))
    vc = with_prev(to_blocks(v))
    s = jnp.einsum('brnqhd,brnkhd->brnhqk', qb, kc, preferred_element_type=F32) * (HEAD_DIM ** -0.5)
    qi = jnp.arange(blk)[:, None]
    ki = jnp.arange(2 * blk)[None, :]
    rel = qi + blk - ki
    band = (rel >= 0) & (rel <= blk)
    kidx = jnp.arange(nb)[:, None] * blk - blk + jnp.arange(2 * blk)[None, :]
    mask = band[None, None, :, :] & (kidx >= 0)[:, None, None, :]
    s = jnp.where(mask, s, -jnp.inf)
    lse = jax.nn.logsumexp(s, axis=-1)
    p = jnp.exp(s - lse[..., None])
    o = jnp.einsum('brnhqk,brnkhd->brnqhd', p.astype(v.dtype), vc)
    o = o.reshape(B, dil, Lp, H, D)[:, :, :L].transpose(0, 2, 1, 3, 4).reshape(B, S, H, D)
    lse = lse.transpose(0, 1, 2, 4, 3).reshape(B, dil, Lp, H)[:, :, :L]
    lse = lse.transpose(0, 2, 1, 3).reshape(B, S, H)
    return o, lse


def _dilated_sample(q, kc, vc, hist, window, dil):
    T = q.shape[1]
    steps = window // dil
    idx = hist + jnp.arange(T)[:, None] - dil * jnp.arange(steps + 1)[None, :]
    valid = idx >= 0
    idx = jnp.maximum(idx, 0)
    kg = kc[:, idx]
    vg = vc[:, idx]
    s = jnp.einsum('nthd,ntkhd->nthk', q, kg, preferred_element_type=F32) * (HEAD_DIM ** -0.5)
    s = jnp.where(valid[None, :, None, :], s, -jnp.inf)
    lse = jax.nn.logsumexp(s, axis=-1)
    p = jnp.exp(s - lse[..., None])
    o = jnp.einsum('nthk,ntkhd->nthd', p.astype(vc.dtype), vg)
    return o, lse


def _merge(outs, lses, w_o):
    wts = jax.nn.softmax(jnp.stack(lses, axis=0), axis=0)
    o = jnp.sum(wts[..., None] * jnp.stack(outs, axis=0).astype(F32), axis=0)
    B, S = o.shape[:2]
    return o.reshape(B, S, ATTN_WIDTH).astype(outs[0].dtype) @ w_o


def setup_inputs(seed: int = 0) -> dict:
    key = jax.random.key(seed)
    ks = jax.random.split(key, 24)

    def nrm(k, shape, scale=1.0):
        return jax.random.normal(k, shape, F32) * scale

    def gain(k, shape):
        return 1.0 + 0.02 * jax.random.normal(k, shape, F32)

    hist = [min(w, PAST_LEN) for w in WINDOWS]
    return {
        "x_prompt": nrm(ks[0], (BATCH, SEQ, D_MODEL)),
        "x_sample": nrm(ks[1], (DEC_BATCH, DEC_SEQ, D_MODEL)),
        "state_pool": nrm(ks[2], (DEC_BATCH, N_A_LAYERS, POOL_HIST, D_MODEL)),
        "cache_kv_w128": nrm(ks[3], (DEC_BATCH, hist[0], 2, N_HEADS, HEAD_DIM)),
        "cache_kv_w512": nrm(ks[4], (DEC_BATCH, hist[1], 2, N_HEADS, HEAD_DIM)),
        "cache_kv_w2048": nrm(ks[5], (DEC_BATCH, hist[2], 2, N_HEADS, HEAD_DIM)),
        "a_norm": gain(ks[6], (N_A_LAYERS, D_MODEL)),
        "pool_w": nrm(ks[7], (N_A_LAYERS, N_POOL_GROUPS, POOL_GROUP, POOL_GROUP), POOL_GROUP ** -0.5),
        "pool_scale": gain(ks[8], (N_A_LAYERS, D_MODEL)),
        "kv_norm": gain(ks[9], (D_MODEL,)),
        "w_kv": nrm(ks[10], (D_MODEL, 2 * N_BRANCH * ATTN_WIDTH), D_MODEL ** -0.5),
        "k_norm": gain(ks[11], (N_BRANCH, HEAD_DIM)),
        "b_norm": gain(ks[12], (N_B_LAYERS, D_MODEL)),
        "w_q": nrm(ks[13], (N_B_LAYERS, D_MODEL, N_BRANCH * ATTN_WIDTH), D_MODEL ** -0.5),
        "q_norm": gain(ks[14], (N_B_LAYERS, N_BRANCH, HEAD_DIM)),
        "w_o": nrm(ks[15], (N_B_LAYERS, ATTN_WIDTH, D_MODEL), ATTN_WIDTH ** -0.5),
        "ffn_norm": gain(ks[16], (DEPTH, D_MODEL)),
        "w_gate": nrm(ks[17], (DEPTH, D_MODEL, D_FF), D_MODEL ** -0.5),
        "w_up": nrm(ks[18], (DEPTH, D_MODEL, D_FF), D_MODEL ** -0.5),
        "w_down": nrm(ks[19], (DEPTH, D_FF, D_MODEL), D_FF ** -0.5),
    }


def reference(x_prompt, x_sample, state_pool, cache_kv_w128, cache_kv_w512, cache_kv_w2048,
              a_norm, pool_w, pool_scale, kv_norm, w_kv, k_norm, b_norm, w_q, q_norm, w_o,
              ffn_norm, w_gate, w_up, w_down):
    S_p = x_prompt.shape[1]
    T = x_sample.shape[1]
    cos_p, sin_p = _rope_tables(jnp.arange(S_p))
    cos_s, sin_s = _rope_tables(PAST_LEN + jnp.arange(T))
    caches = (cache_kv_w128, cache_kv_w512, cache_kv_w2048)

    xp, xs = x_prompt, x_sample
    pool_p, pool_s = [], []
    kp = vp = None
    kv_cat = []
    kv_new_p = []
    for layer in range(DEPTH):
        if layer < N_A_LAYERS:
            i = layer
            up = _rmsnorm(xp, a_norm[i])
            us = _rmsnorm(xs, a_norm[i])
            us_ext = jnp.concatenate([state_pool[:, i].astype(us.dtype), us], axis=1)
            xp = xp + _pool_mixer(up, 0, pool_w[i], pool_scale[i])
            xs = xs + _pool_mixer(us_ext, POOL_HIST, pool_w[i], pool_scale[i])
            pool_p.append(up[:, -POOL_HIST:])
            pool_s.append(us_ext[:, -POOL_HIST:])
        else:
            j = layer - N_A_LAYERS
            if j == 0:
                kp, vp = _shared_kv(xp, kv_norm, w_kv, k_norm, cos_p, sin_p)
                ks_, vs_ = _shared_kv(xs, kv_norm, w_kv, k_norm, cos_s, sin_s)
                for g in range(N_BRANCH):
                    new_rows = jnp.stack([ks_[:, :, g], vs_[:, :, g]], axis=2)
                    kv_cat.append(jnp.concatenate([caches[g].astype(new_rows.dtype), new_rows], axis=1))
                    keep = min(WINDOWS[g], S_p)
                    kv_new_p.append(jnp.stack([kp[:, -keep:, g], vp[:, -keep:, g]], axis=2))
            qp = _queries(xp, b_norm[j], w_q[j], q_norm[j], cos_p, sin_p)
            qs = _queries(xs, b_norm[j], w_q[j], q_norm[j], cos_s, sin_s)
            outs_p, lses_p, outs_s, lses_s = [], [], [], []
            for g in range(N_BRANCH):
                o, l = _dilated_prompt(qp[:, :, g], kp[:, :, g], vp[:, :, g], WINDOWS[g], DILATIONS[g])
                outs_p.append(o)
                lses_p.append(l)
                o, l = _dilated_sample(qs[:, :, g], kv_cat[g][:, :, 0], kv_cat[g][:, :, 1],
                                       caches[g].shape[1], WINDOWS[g], DILATIONS[g])
                outs_s.append(o)
                lses_s.append(l)
            xp = xp + _merge(outs_p, lses_p, w_o[j])
            xs = xs + _merge(outs_s, lses_s, w_o[j])
        xp = xp + _swiglu(_rmsnorm(xp, ffn_norm[layer]), w_gate[layer], w_up[layer], w_down[layer])
        xs = xs + _swiglu(_rmsnorm(xs, ffn_norm[layer]), w_gate[layer], w_up[layer], w_down[layer])

    pool_prompt = jnp.stack(pool_p, axis=1)
    pool_sample = jnp.stack(pool_s, axis=1)
    kv128_prompt = kv_new_p[0]
    kv512_prompt = kv_new_p[1]
    kv2048_prompt = kv_new_p[2]
    kv128_sample = kv_cat[0][:, -caches[0].shape[1]:]
    kv512_sample = kv_cat[1][:, -caches[1].shape[1]:]
    kv2048_sample = kv_cat[2][:, -caches[2].shape[1]:]
    return (xp, xs, pool_prompt, pool_sample, kv128_prompt, kv128_sample,
            kv512_prompt, kv512_sample, kv2048_prompt, kv2048_sample)
```

```cpp
#include <hip/hip_runtime.h>
#include <hip/hip_cooperative_groups.h>
#include <cstdio>
#include <cstdint>
namespace cg = cooperative_groups;

constexpr int MP = 16384, MS = 256, MT = MP + MS, DM = 1024, FF = 2816, SEQ = 4096, NTM = MT / 256;
constexpr float EPS = 1e-6f;
constexpr float C2 = 0.125f * 1.4426950408889634f;
constexpr size_t O_YP = 0, O_YS = O_YP + (size_t)MP * DM, O_PP = O_YS + (size_t)MS * DM, O_PS = O_PP + 4 * 2 * 15 * 1024,
                 O_KP0 = O_PS + 32 * 2 * 15 * 1024, O_KS0 = O_KP0 + (size_t)4 * 128 * 2048, O_KP1 = O_KS0 + (size_t)32 * 128 * 2048,
                 O_KS1 = O_KP1 + (size_t)4 * 512 * 2048, O_KP2 = O_KS1 + (size_t)32 * 512 * 2048, O_KS2 = O_KP2 + (size_t)4 * 2048 * 2048,
                 O_END = O_KS2 + (size_t)32 * 2048 * 2048;
constexpr size_t AL(size_t x) { return (x + 65535) & ~(size_t)65535; }
constexpr size_t WS_WPOOL = 0;
constexpr size_t WS_WGU = AL(WS_WPOOL + (size_t)8 * 65536 * 2);
constexpr size_t WS_WDN = AL(WS_WGU + (size_t)4 * 5632 * 1024 * 2);
constexpr size_t WS_WKVQ = AL(WS_WDN + (size_t)4 * 1024 * 2816 * 2);
constexpr size_t WS_WQ1 = AL(WS_WKVQ + (size_t)9216 * 1024 * 2);
constexpr size_t WS_WO = AL(WS_WQ1 + (size_t)3072 * 1024 * 2);
constexpr size_t WS_DBUF = AL(WS_WO + (size_t)2 * 1024 * 1024 * 2);
constexpr size_t WS_XB = AL(WS_DBUF + (size_t)4 * MT * 256 * 2);
constexpr size_t WS_H = AL(WS_XB + (size_t)MT * 1024 * 2);
constexpr size_t WS_KB = AL(WS_H + (size_t)MT * FF * 2);
constexpr size_t WS_VB = AL(WS_KB + (size_t)3 * MP * 1024 * 2);
constexpr size_t WS_QB = AL(WS_VB + (size_t)3 * MP * 1024 * 2);
constexpr size_t WS_OG = AL(WS_QB + (size_t)3 * MP * 1024 * 2);
constexpr size_t WS_LSE = AL(WS_OG + (size_t)3 * MP * 1024 * 2);
constexpr size_t WS_OB = AL(WS_LSE + (size_t)3 * MP * 16 * 4);
constexpr size_t WS_QS = AL(WS_OB + (size_t)MT * 1024 * 2);
constexpr size_t WS_SSQ = AL(WS_QS + (size_t)256 * 3072 * 4);
constexpr size_t WS_ROPE = AL(WS_SSQ + (size_t)8 * MT * 4);
constexpr size_t WS_CTL = AL(WS_ROPE + (size_t)2 * 4104 * 32 * 4);
constexpr size_t CKV_ROWS = 136 + 520 + 1032;
constexpr size_t WS_CK = AL(WS_CTL + 32768);
constexpr size_t WS_CV = AL(WS_CK + (size_t)512 * CKV_ROWS * 64 * 2);
constexpr size_t WS_END = AL(WS_CV + (size_t)512 * CKV_ROWS * 64 * 2);

struct Params {
    const float *x_prompt, *x_sample, *state_pool, *cache0, *cache1, *cache2, *a_norm, *pool_w, *pool_scale, *kv_norm, *w_kv, *k_norm, *b_norm, *w_q, *q_norm, *w_o,
        *ffn_norm, *w_gate, *w_up, *w_down;
    float* out; unsigned char* ws; int lo, hi;
};

__device__ __forceinline__ int opaque_tid() { int t = threadIdx.x; asm volatile("" : "+v"(t)); return t; }
namespace pg8 {
#define PG8_LAS __attribute__((address_space(3)))
typedef unsigned short bf16_t;
typedef short bf16x8 __attribute__((ext_vector_type(8)));
typedef float f32x4 __attribute__((ext_vector_type(4)));
typedef unsigned u32x4 __attribute__((ext_vector_type(4)));
typedef unsigned u32x2 __attribute__((ext_vector_type(2)));
constexpr int BM = 256, BK = 64, HALF = 128, HTB = HALF * BK * 2  , STAGE_BYTES = 8 * HTB, NXCD = 8, WGM = 8;

__host__ __device__ __forceinline__ int lds_byte(int r, int c) { const int st = (r >> 4) * 2 + (c >> 5), rr = r & 15, cc = c & 31, ob = rr * 64 + cc * 2; return st * 1024 + (ob ^ (((ob >> 9) & 1) << 5)); }
__host__ __device__ __forceinline__ void stage_rc(int b, int& R, int& C) { const int st = b / 1024, sb = b % 1024, swz = sb ^ (((sb >> 9) & 1) << 5); R = (st >> 1) * 16 + swz / 64; C = (st & 1) * 32 + (swz % 64) / 2; }
__host__ __device__ __forceinline__ int perm32(int rho) { const int n = rho >> 4, i = rho & 15; return 8 * (i >> 2) + 4 * n + (i & 3); }

struct Unit { int pm, pn, rowt, colt; };
struct Gemm { const bf16_t* A; const bf16_t* Bt; int M, N, K; };

struct StaticOrder {
    int nM, nN, nwg, G, c, mode; unsigned* cnt;
    __device__ void init(int M, int N, int G_, int c_, int mode_) { nM = M / BM; nN = N / BM; nwg = nM * nN; G = G_; c = c_; mode = mode_; cnt = nullptr; }
    __device__ bool next(int i, Unit& u) const {
        if (mode == 4) { if (i > 0) return false; u.pm = nM; u.pn = c; u.rowt = nM; u.colt = c; return true; }
        const long L = (long)i * G + c;
        int wgid = (int)L, nw = nwg, nm = nM;
        if (mode == 3) {
            if (L >= nwg + nN) return false;
            if (L < nN) { u.pm = nM; u.pn = (int)L; u.rowt = nM; u.colt = (int)L; return true; }
            wgid -= nN;
        } else if (L >= nwg) return false;
        if (mode == 1) { const int g = wgid / NTM, m = wgid % NTM; u.pm = g * NTM + m; u.pn = g; u.rowt = m; u.colt = g; return true; }
        { const int q = nw / NXCD, r = nw % NXCD, xcd = wgid % NXCD, off = wgid / NXCD; wgid = (xcd < r ? xcd * (q + 1) : r * (q + 1) + (xcd - r) * q) + off; }
        const int nig = WGM * nN, gid = wgid / nig, fm = gid * WGM, gsz = (nm - fm) < WGM ? (nm - fm) : WGM;
        u.pm = fm + ((wgid % nig) % gsz); u.pn = (wgid % nig) / gsz; u.rowt = u.pm; u.colt = u.pn; return true;
    }
    __device__ __forceinline__ void a_ready(const Unit&) const {}
    __device__ __forceinline__ void done(const Unit& u) const {
        if (mode == 3 && u.rowt == nM) {
            __threadfence();
            __builtin_amdgcn_s_barrier();
            if (threadIdx.x == 0) atomicAdd(cnt, 1u);
        }
    }
};

__device__ __forceinline__ unsigned cvt_pk_bf16(float lo, float hi) { unsigned r; asm volatile("v_cvt_pk_bf16_f32 %0, %1, %2" : "=v"(r) : "v"(lo), "v"(hi)); return r; }


struct EpiResid {
    static constexpr bool PERM = false, AFTER_DRAIN = false;
    const float* xin_p; const float* xin_s; float* X; const float* scale; bf16_t* xb; float* ssq;
    __device__ __forceinline__ void operator()(const f32x4 (&acc)[2][2][4][2], const Unit& u, int wr, int wc, int fr, int fq) const {
        const int colbase = u.colt * BM + wc * 32 + fq * 4;
        f32x4 sc[2][2];
#pragma unroll
        for (int bj = 0; bj < 2; ++bj)
#pragma unroll
            for (int n = 0; n < 2; ++n) sc[bj][n] = scale ? *(const f32x4*)(scale + colbase + bj * HALF + n * 16) : (f32x4){1.f, 1.f, 1.f, 1.f};
#pragma unroll
        for (int ai = 0; ai < 2; ++ai) {
            const int row0 = u.rowt * BM + ai * HALF + wr * 64 + fr;
            const float* xi0 = (row0 < MP) ? xin_p + (size_t)row0 * DM : xin_s + (size_t)(row0 - MP) * DM;
            f32x4 xv[4][2][2];
#pragma unroll
            for (int m = 0; m < 4; ++m)
#pragma unroll
                for (int bj = 0; bj < 2; ++bj)
#pragma unroll
                    for (int n = 0; n < 2; ++n) xv[m][bj][n] = *(const f32x4*)(xi0 + (size_t)m * 16 * DM + colbase + bj * HALF + n * 16);
            asm volatile("" ::: "memory");
#pragma unroll
            for (int m = 0; m < 4; ++m) {
                const int row = row0 + m * 16;
                float* xo = X + (size_t)row * DM; float ss = 0.f;
#pragma unroll
                for (int bj = 0; bj < 2; ++bj)
#pragma unroll
                    for (int n = 0; n < 2; ++n) {
                        const int col = colbase + bj * HALF + n * 16;
                        const f32x4 v = xv[m][bj][n] + acc[ai][bj][m][n] * sc[bj][n];
                        *(f32x4*)(xo + col) = v;
                        if (xb) { u32x2 w; w.x = cvt_pk_bf16(v[0], v[1]); w.y = cvt_pk_bf16(v[2], v[3]); *(u32x2*)(xb + (size_t)row * DM + col) = w; }
                        ss += (v[0] * v[0] + v[1] * v[1]) + (v[2] * v[2] + v[3] * v[3]);
                    }
                if (ssq) { ss += __shfl_xor(ss, 16); ss += __shfl_xor(ss, 32); if (fq == 0) atomicAdd(ssq + row, ss); }
            }
            asm volatile("" ::: "memory");
        }
    }
};

struct EpiGU {
    static constexpr bool PERM = false, AFTER_DRAIN = false;
    const float* ssq; bf16_t* H;
    __device__ __forceinline__ void operator()(const f32x4 (&acc)[2][2][4][2], const Unit& u, int wr, int wc, int fr, int fq) const {
        float rsv[2][4];
#pragma unroll
        for (int ai = 0; ai < 2; ++ai)
#pragma unroll
            for (int m = 0; m < 4; ++m) rsv[ai][m] = ssq[u.rowt * BM + ai * HALF + wr * 64 + m * 16 + fr];
#pragma unroll
        for (int ai = 0; ai < 2; ++ai)
#pragma unroll
            for (int m = 0; m < 4; ++m) {
                const int row = u.rowt * BM + ai * HALF + wr * 64 + m * 16 + fr;
                const float rs = __builtin_amdgcn_rsqf(rsv[ai][m] * (1.0f / DM) + EPS);
#pragma unroll
                for (int bj = 0; bj < 2; ++bj) {
                    const int hcol = u.colt * 128 + bj * 64 + wc * 16 + fq * 4;
                    const f32x4 g = acc[ai][bj][m][0] * rs, up = acc[ai][bj][m][1] * rs; float o[4];
#pragma unroll
                    for (int e = 0; e < 4; ++e) { const float sg = __builtin_amdgcn_rcpf(1.0f + __builtin_amdgcn_exp2f(-1.4426950408889634f * g[e])); o[e] = g[e] * sg * up[e]; }
                    u32x2 w; w.x = cvt_pk_bf16(o[0], o[1]); w.y = cvt_pk_bf16(o[2], o[3]);
                    *(u32x2*)(H + (size_t)row * FF + hcol) = w;
                }
            }
    }
};

__device__ __forceinline__ size_t hm_off(int g, int row, int h) {
    const int pos = row & (SEQ - 1), b = row >> 12, sh = 2 * g;
    const int sig = ((pos & ((1 << sh) - 1)) << (12 - sh)) + (pos >> sh);
    return ((size_t)((g * 4 + b) * 16 + h) * SEQ + sig) * 64;
}
__device__ __forceinline__ size_t ckv_off(int g, int n, int h, int idxc) {
    const size_t gbase = g == 0 ? 0 : (g == 1 ? (size_t)512 * 136 : (size_t)512 * (136 + 520));
    const int rc = g == 0 ? 136 : (g == 1 ? 520 : 1032);
    return (gbase + (size_t)(n * 16 + h) * rc + idxc) * 64;
}
struct EpiQKV {
    static constexpr bool PERM = false, AFTER_DRAIN = false;
    const float* ssq; int tile_base; const float* k_norm; const float* q_norm; const float* ropec; const float* ropes;
    bf16_t* Kb; bf16_t* Vb; bf16_t* Qb; float* QS; float* out; bf16_t* CK; bf16_t* CV;
    __device__ __forceinline__ void operator()(const f32x4 (&acc)[2][2][4][2], const Unit& u, int wr, int wc, int fr, int fq) const {
        const int tile = u.colt + tile_base, type = tile / 12, G = 4 * (tile % 12) + wc, g = G >> 4, h = G & 15;
        const int hist = 128 << (2 * g);
        const float* gn = (type == 0 ? k_norm : q_norm) + g * 64;
        const size_t okp = g == 0 ? O_KP0 : (g == 1 ? O_KP1 : O_KP2), oks = g == 0 ? O_KS0 : (g == 1 ? O_KS1 : O_KS2);
        f32x4 gA[2], gB[2];
#pragma unroll
        for (int n = 0; n < 2; ++n) { gA[n] = *(const f32x4*)(gn + n * 16 + fq * 4); gB[n] = *(const f32x4*)(gn + 32 + n * 16 + fq * 4); }
#pragma unroll
        for (int ai = 0; ai < 2; ++ai)
#pragma unroll
            for (int mh = 0; mh < 2; ++mh) {
                float sq[2]; f32x4 cs[2][2], sn[2][2];
#pragma unroll
                for (int mm = 0; mm < 2; ++mm) {
                    const int row = u.rowt * BM + ai * HALF + wr * 64 + (2 * mh + mm) * 16 + fr;
                    sq[mm] = ssq[row];
                    if (type != 1) {
                        const int pi = row < MP ? (row & (SEQ - 1)) : SEQ + ((row - MP) & 7);
#pragma unroll
                        for (int n = 0; n < 2; ++n) { cs[mm][n] = *(const f32x4*)(ropec + pi * 32 + n * 16 + fq * 4); sn[mm][n] = *(const f32x4*)(ropes + pi * 32 + n * 16 + fq * 4); }
                    }
                }
                asm volatile("" ::: "memory");
#pragma unroll
                for (int mm = 0; mm < 2; ++mm) {
                    const int m = 2 * mh + mm;
                    const int row = u.rowt * BM + ai * HALF + wr * 64 + m * 16 + fr;
                    const float rs = __builtin_amdgcn_rsqf(sq[mm] * (1.0f / DM) + EPS);
                    f32x4 v[2][2];
#pragma unroll
                    for (int bj = 0; bj < 2; ++bj)
#pragma unroll
                        for (int n = 0; n < 2; ++n) v[bj][n] = acc[ai][bj][m][n] * rs;
                    if (type != 1) {
                        float ss = 0.f;
#pragma unroll
                        for (int bj = 0; bj < 2; ++bj)
#pragma unroll
                            for (int n = 0; n < 2; ++n) ss += (v[bj][n][0] * v[bj][n][0] + v[bj][n][1] * v[bj][n][1]) + (v[bj][n][2] * v[bj][n][2] + v[bj][n][3] * v[bj][n][3]);
                        ss += __shfl_xor(ss, 16); ss += __shfl_xor(ss, 32);
                        float hr = __builtin_amdgcn_rsqf(ss * (1.0f / 64.0f) + EPS);
                        if (type == 2) hr *= C2;
#pragma unroll
                        for (int n = 0; n < 2; ++n) {
                            const f32x4 a = v[0][n] * hr * gA[n], b = v[1][n] * hr * gB[n];
                            v[0][n] = a * cs[mm][n] - b * sn[mm][n]; v[1][n] = b * cs[mm][n] + a * sn[mm][n];
                        }
                    }
#pragma unroll
                    for (int bj = 0; bj < 2; ++bj)
#pragma unroll
                        for (int n = 0; n < 2; ++n) {
                            const int d = bj * 32 + n * 16 + fq * 4; const f32x4 x = v[bj][n];
                            u32x2 w; w.x = cvt_pk_bf16(x[0], x[1]); w.y = cvt_pk_bf16(x[2], x[3]);
                            if (type == 2) {
                                if (row < MP) *(u32x2*)(Qb + hm_off(g, row, h) + d) = w;
                                else *(f32x4*)(QS + (size_t)(row - MP) * 3072 + G * 64 + d) = x;
                            } else {
                                if (row < MP) {
                                    *(u32x2*)((type == 0 ? Kb : Vb) + hm_off(g, row, h) + d) = w;
                                    const int s = row & (SEQ - 1), b = row >> 12;
                                    if (s >= SEQ - hist) *(f32x4*)(out + okp + ((size_t)(b * hist + s - (SEQ - hist)) * 2 + type) * DM + h * 64 + d) = x;
                                } else {
                                    const int q = row - MP, n_ = q >> 3, t = q & 7;
                                    *(f32x4*)(out + oks + ((size_t)(n_ * hist + hist - 8 + t) * 2 + type) * DM + h * 64 + d) = x;
                                    *(u32x2*)((type == 0 ? CK : CV) + ckv_off(g, n_, h, (g == 2 ? 1024 : hist) + t) + d) = w;
                                }
                            }
                        }
                }
                asm volatile("" ::: "memory");
            }
    }
};

template <class Epi, class Sched, bool ALIGN_EPI = false, bool SP2 = false>
__device__ __forceinline__ void gemm_phase(PG8_LAS unsigned char* lds, const Gemm g, const Sched& S, const Epi& E) {
    const int tid = opaque_tid(), wid = __builtin_amdgcn_readfirstlane(tid >> 6), lane = tid & 63, wr = wid >> 2, wc = wid & 3, fr = lane & 15, fq = lane >> 4;
    const int K = g.K, nt = K / BK;
    unsigned voffA[2], voffB[2];
#pragma unroll
    for (int i = 0; i < 2; ++i) { int R, C; stage_rc(tid * 16 + i * 8192, R, C); const int Rb = Epi::PERM ? ((R & ~31) + perm32(R & 31)) : R;
        voffA[i] = (unsigned)(R * K + C) * 2u; voffB[i] = (unsigned)(Rb * K + C) * 2u; }
    const size_t kstep = (size_t)(BK * 2);
    const size_t hstep = (size_t)HALF * K * 2;
    const size_t tstep = 2 * hstep;
    const unsigned ldsw = (unsigned)wid * 1024u;
    const int aoff = lds_byte(wr * 64 + fr, fq * 8), boff = lds_byte(wc * 32 + fr, fq * 8);
#define PG8_SA(b, h) (((b) * 2 + (h)) * HTB)
#define PG8_SB(b, h) ((4 + (b) * 2 + (h)) * HTB)
#define PG8_STAGE(bufoff, gbase, voff) do { _Pragma("unroll") for (int _i = 0; _i < 2; ++_i) \
        __builtin_amdgcn_global_load_lds((const unsigned*)((const char*)(gbase) + (voff)[_i]), (PG8_LAS unsigned*)(lds + (bufoff) + ldsw + _i * 8192), 16, 0, 0); } while (0)
#define PG8_LDA(dst, b, h) do { _Pragma("unroll") for (int m = 0; m < 4; ++m) _Pragma("unroll") for (int k = 0; k < 2; ++k) dst[m][k] = *(const PG8_LAS bf16x8*)(lds + PG8_SA(b, h) + aoff + m * 2048 + k * 1024); } while (0)
#define PG8_LDB(dst, b, h) do { _Pragma("unroll") for (int n = 0; n < 2; ++n) _Pragma("unroll") for (int k = 0; k < 2; ++k) dst[n][k] = *(const PG8_LAS bf16x8*)(lds + PG8_SB(b, h) + boff + n * 2048 + k * 1024); } while (0)
#define PG8_MMA(ai, bj, At, Bt) do { __builtin_amdgcn_s_setprio(1); _Pragma("unroll") for (int m = 0; m < 4; ++m) _Pragma("unroll") for (int n = 0; n < 2; ++n) _Pragma("unroll") for (int k = 0; k < 2; ++k) \
        acc[ai][bj][m][n] = __builtin_amdgcn_mfma_f32_16x16x32_bf16(Bt[n][k], At[m][k], acc[ai][bj][m][n], 0, 0, 0); __builtin_amdgcn_s_setprio(0); } while (0)
#define PG8_WAIT_V(n) asm volatile("s_waitcnt vmcnt(" #n ")" ::: "memory")
#define PG8_WAIT_L(n) asm volatile("s_waitcnt lgkmcnt(" #n ")" ::: "memory")
#define PG8_BAR __builtin_amdgcn_s_barrier()
#define PG8_SCHED __builtin_amdgcn_sched_barrier(0)
    Unit cur, nxt; int ui = 0;
    if (!S.next(0, cur)) return;
    f32x4 acc[2][2][4][2];
#pragma unroll
    for (int a = 0; a < 2; ++a)
#pragma unroll
        for (int b = 0; b < 2; ++b)
#pragma unroll
            for (int m = 0; m < 4; ++m)
#pragma unroll
                for (int n = 0; n < 2; ++n) acc[a][b][m][n] = (f32x4){0.f, 0.f, 0.f, 0.f};
    bf16x8 At[4][2], B0[2][2], B1[2][2];
    const char* cA = (const char*)g.A + (size_t)cur.pm * tstep; const char* cB = (const char*)g.Bt + (size_t)cur.pn * tstep;
    S.a_ready(cur);
    if constexpr (SP2) {
        PG8_STAGE(PG8_SB(0, 0), cB, voffB); PG8_STAGE(PG8_SB(0, 1), cB + hstep, voffB); PG8_STAGE(PG8_SA(0, 0), cA, voffA); PG8_STAGE(PG8_SA(0, 1), cA + hstep, voffA);
        if (wr == 1) PG8_BAR;
        PG8_WAIT_V(2); PG8_BAR;
        PG8_STAGE(PG8_SB(1, 0), cB + kstep, voffB); PG8_STAGE(PG8_SA(1, 0), cA + kstep, voffA); PG8_STAGE(PG8_SB(1, 1), cB + hstep + kstep, voffB);
        PG8_WAIT_V(6); PG8_BAR;
    } else {
        PG8_STAGE(PG8_SB(0, 0), cB, voffB); PG8_STAGE(PG8_SA(0, 0), cA, voffA); PG8_STAGE(PG8_SB(0, 1), cB + hstep, voffB); PG8_STAGE(PG8_SA(0, 1), cA + hstep, voffA);
        if (wr == 1) PG8_BAR;
        PG8_WAIT_V(4); PG8_BAR;
        PG8_STAGE(PG8_SB(1, 0), cB + kstep, voffB); PG8_STAGE(PG8_SA(1, 0), cA + kstep, voffA); PG8_STAGE(PG8_SB(1, 1), cB + hstep + kstep, voffB);
        PG8_WAIT_V(6); PG8_BAR;
    }
    for (;;) {
        const bool has_next = S.next(ui + 1, nxt);
        const char* nA = has_next ? (const char*)g.A + (size_t)nxt.pm * tstep : cA; const char* nB = has_next ? (const char*)g.Bt + (size_t)nxt.pn * tstep : cB;
        for (int t = 0; t < nt; t += 2) {
            const bool last = (t == nt - 2);
            const char* a1 = cA + (size_t)(t + 1) * kstep;
            const char* a2 = last ? nA : cA + (size_t)(t + 2) * kstep; const char* b2 = last ? nB : cB + (size_t)(t + 2) * kstep;
            const char* a3 = a2 + kstep; const char* b3 = b2 + kstep;
            if (last && has_next) S.a_ready(nxt);
            if constexpr (SP2) {
            PG8_LDB(B0, 0, 0); PG8_LDB(B1, 0, 1); PG8_SCHED; PG8_LDA(At, 0, 0); PG8_STAGE(PG8_SA(1, 1), a1 + hstep, voffA);
            PG8_WAIT_V(8); PG8_WAIT_L(0); PG8_BAR; PG8_MMA(0, 0, At, B0); PG8_MMA(0, 1, At, B1); PG8_BAR; PG8_SCHED;
            PG8_LDA(At, 0, 1); PG8_STAGE(PG8_SB(0, 0), b2, voffB); PG8_STAGE(PG8_SB(0, 1), b2 + hstep, voffB); PG8_STAGE(PG8_SA(0, 0), a2, voffA);
            PG8_WAIT_V(8); PG8_WAIT_L(0); PG8_BAR; PG8_MMA(1, 0, At, B0); PG8_MMA(1, 1, At, B1); PG8_BAR; PG8_SCHED;
            PG8_LDB(B0, 1, 0); PG8_LDB(B1, 1, 1); PG8_SCHED; PG8_LDA(At, 1, 0); PG8_STAGE(PG8_SA(0, 1), a2 + hstep, voffA);
            PG8_WAIT_V(8); PG8_WAIT_L(0); PG8_BAR; PG8_MMA(0, 0, At, B0); PG8_MMA(0, 1, At, B1); PG8_BAR; PG8_SCHED;
            PG8_LDA(At, 1, 1); PG8_STAGE(PG8_SB(1, 0), b3, voffB); PG8_STAGE(PG8_SB(1, 1), b3 + hstep, voffB); PG8_STAGE(PG8_SA(1, 0), a3, voffA);
            PG8_WAIT_V(8); PG8_WAIT_L(0); PG8_BAR; PG8_MMA(1, 0, At, B0); PG8_MMA(1, 1, At, B1); PG8_BAR; PG8_SCHED;
            } else {
            PG8_LDB(B0, 0, 0); PG8_SCHED; PG8_LDA(At, 0, 0); PG8_STAGE(PG8_SA(1, 1), a1 + hstep, voffA);
            PG8_WAIT_L(8); PG8_BAR; PG8_WAIT_L(0); PG8_MMA(0, 0, At, B0); PG8_BAR; PG8_SCHED;
            PG8_LDB(B1, 0, 1); PG8_STAGE(PG8_SB(0, 0), b2, voffB);
            PG8_BAR; PG8_WAIT_L(0); PG8_MMA(0, 1, At, B1); PG8_BAR;
            PG8_LDA(At, 0, 1); PG8_STAGE(PG8_SA(0, 0), a2, voffA);
            PG8_BAR; PG8_WAIT_L(0); PG8_MMA(1, 0, At, B0); PG8_BAR; PG8_SCHED;
            PG8_STAGE(PG8_SB(0, 1), b2 + hstep, voffB);
            PG8_WAIT_V(6); PG8_BAR; PG8_MMA(1, 1, At, B1); PG8_BAR;
            PG8_LDB(B0, 1, 0); PG8_SCHED; PG8_LDA(At, 1, 0); PG8_STAGE(PG8_SA(0, 1), a2 + hstep, voffA);
            PG8_WAIT_L(8); PG8_BAR; PG8_WAIT_L(0); PG8_MMA(0, 0, At, B0); PG8_BAR; PG8_SCHED;
            PG8_LDB(B1, 1, 1); PG8_STAGE(PG8_SB(1, 0), b3, voffB);
            PG8_BAR; PG8_WAIT_L(0); PG8_MMA(0, 1, At, B1); PG8_BAR;
            PG8_LDA(At, 1, 1); PG8_STAGE(PG8_SA(1, 0), a3, voffA);
            PG8_BAR; PG8_WAIT_L(0); PG8_MMA(1, 0, At, B0); PG8_BAR; PG8_SCHED;
            PG8_STAGE(PG8_SB(1, 1), b3 + hstep, voffB);
            PG8_WAIT_V(6); PG8_BAR; PG8_MMA(1, 1, At, B1); PG8_BAR;
            }
        }
        if constexpr (ALIGN_EPI) { if (wr == 0) PG8_BAR; }
        if constexpr (!Epi::AFTER_DRAIN) { E(acc, cur, wr, wc, fr, fq); S.done(cur); }
        if (!has_next) break;
#pragma unroll
        for (int a = 0; a < 2; ++a)
#pragma unroll
            for (int b = 0; b < 2; ++b)
#pragma unroll
                for (int m = 0; m < 4; ++m)
#pragma unroll
                    for (int n = 0; n < 2; ++n) acc[a][b][m][n] = (f32x4){0.f, 0.f, 0.f, 0.f};
        cur = nxt; cA = nA; cB = nB; ++ui;
        if constexpr (ALIGN_EPI) { if (wr == 1) PG8_BAR; }
    }
    PG8_WAIT_V(0);
    if constexpr (!ALIGN_EPI) { if (wr == 0) PG8_BAR; }
    PG8_BAR;
    if constexpr (Epi::AFTER_DRAIN) { E.fused(acc, cur, wr, wc, fr, fq, lds, wid, lane); S.done(cur); }
#undef PG8_SA
#undef PG8_SB
#undef PG8_STAGE
#undef PG8_LDA
#undef PG8_LDB
#undef PG8_MMA
#undef PG8_WAIT_V
#undef PG8_WAIT_L
#undef PG8_BAR
#undef PG8_SCHED
}
}

#define LAS __attribute__((address_space(3)))
typedef unsigned short bf16_t;
typedef short bf16x8 __attribute__((ext_vector_type(8)));
typedef short s16x4 __attribute__((ext_vector_type(4)));
typedef float f32x4 __attribute__((ext_vector_type(4)));
typedef float f32x16 __attribute__((ext_vector_type(16)));
typedef unsigned u32x4 __attribute__((ext_vector_type(4)));
typedef unsigned u32x2 __attribute__((ext_vector_type(2)));
constexpr int NWAVES = 8, NTHREADS = 512;
constexpr int LDS_BYTES = 147456;

__device__ __forceinline__ unsigned pk_bf16(float lo, float hi) { return pg8::cvt_pk_bf16(lo, hi); }

__constant__ double INV_FREQ[32] = {1.0, 0.7498942093324559, 0.5623413251903491, 0.4216965034285822, 0.31622776601683794, 0.23713737056616552, 0.1778279410038923, 0.1333521432163324, 0.1,
    0.07498942093324558, 0.05623413251903491, 0.042169650342858224, 0.03162277660168379, 0.023713737056616554, 0.01778279410038923, 0.01333521432163324, 0.01, 0.007498942093324558,
    0.005623413251903491, 0.004216965034285823, 0.0031622776601683794, 0.0023713737056616554, 0.0017782794100389228, 0.001333521432163324, 0.001, 0.0007498942093324559,
    0.0005623413251903491, 0.00042169650342858224, 0.00031622776601683794, 0.00023713737056616554, 0.00017782794100389227, 0.0001333521432163324};

__device__ __forceinline__ void wconv_item(const float* src, const float* src2, int K, int Nsrc, bf16_t* dst, int Ndst, int mode, const float* gain, LAS float* scr, int item, int lane) {
    const int nblk = Ndst / 32, kb = item / nblk, nb = item % nblk, k0 = 64 * kb, n0 = 32 * nb;
    const int np = n0 + (lane & 31);
    const float* s = src; int col = np;
    if (mode == 1) { col = (np >> 5) * 16 + (np & 15); if ((np >> 4) & 1) s = src2; }
    else if (mode == 2) { const int pn = np >> 8, bj = (np >> 7) & 1, wc = (np >> 5) & 3, j = np & 31; col = (4 * pn + wc) * 64 + 32 * bj + j; }
    float wv[32];
#pragma unroll
    for (int i = 0; i < 32; ++i) { const int kk = 2 * i + (lane >> 5); wv[i] = s[(size_t)(k0 + kk) * Nsrc + col]; }
    if (gain) {
#pragma unroll
        for (int i = 0; i < 32; ++i) { const int kk = 2 * i + (lane >> 5); wv[i] *= gain[k0 + kk]; }
    }
#pragma unroll
    for (int i = 0; i < 32; ++i) { const int kk = 2 * i + (lane >> 5); scr[kk * 33 + (lane & 31)] = wv[i]; }
    asm volatile("s_waitcnt lgkmcnt(0)" ::: "memory");
    const int c = lane & 7;
#pragma unroll
    for (int j = 0; j < 4; ++j) { const int n = (lane >> 3) + 8 * j; const LAS float* t = scr + (8 * c) * 33 + n;
        u32x4 o; o.x = pk_bf16(t[0 * 33], t[1 * 33]); o.y = pk_bf16(t[2 * 33], t[3 * 33]); o.z = pk_bf16(t[4 * 33], t[5 * 33]); o.w = pk_bf16(t[6 * 33], t[7 * 33]);
        *(u32x4*)(dst + (size_t)(n0 + n) * K + k0 + 8 * c) = o; }
    asm volatile("s_waitcnt lgkmcnt(0)" ::: "memory");
}

__device__ __forceinline__ void prep_weights(const Params& p, LAS unsigned char* lds, int gw, int NGW, int wave, int lane) {
    LAS float* scr = (LAS float*)(lds + wave * 8704);
    unsigned char* ws = p.ws;
    for (int id = 0; id < 21; ++id) {
        const float* src; const float* src2 = nullptr; int K, Nsrc, Ndst, mode = 0; bf16_t* dst; const float* gain = nullptr;
        if (id < 8) { src = p.pool_w + (size_t)id * 65536; K = 256; Nsrc = 256; Ndst = 256; dst = (bf16_t*)(ws + WS_WPOOL) + (size_t)id * 65536; }
        else if (id < 12) { const int l = id - 8; src = p.w_gate + (size_t)l * DM * FF; src2 = p.w_up + (size_t)l * DM * FF; K = DM; Nsrc = FF; Ndst = 2 * FF; mode = 1;
                            dst = (bf16_t*)(ws + WS_WGU) + (size_t)l * 2 * FF * DM; gain = p.ffn_norm + l * DM; }
        else if (id < 16) { const int l = id - 12; src = p.w_down + (size_t)l * FF * DM; K = FF; Nsrc = DM; Ndst = DM; dst = (bf16_t*)(ws + WS_WDN) + (size_t)l * DM * FF; }
        else if (id == 16) { src = p.w_kv; K = DM; Nsrc = 6144; Ndst = 6144; mode = 2; dst = (bf16_t*)(ws + WS_WKVQ); gain = p.kv_norm; }
        else if (id == 17) { src = p.w_q; K = DM; Nsrc = 3072; Ndst = 3072; mode = 2; dst = (bf16_t*)(ws + WS_WKVQ) + (size_t)6144 * DM; gain = p.b_norm; }
        else if (id == 18) { src = p.w_q + (size_t)DM * 3072; K = DM; Nsrc = 3072; Ndst = 3072; mode = 2; dst = (bf16_t*)(ws + WS_WQ1); gain = p.b_norm + DM; }
        else { const int j = id - 19; src = p.w_o + (size_t)j * DM * DM; K = DM; Nsrc = DM; Ndst = DM; dst = (bf16_t*)(ws + WS_WO) + (size_t)j * DM * DM; }
        const int nitems = (K / 64) * (Ndst / 32);
        for (int it = gw; it < nitems; it += NGW) wconv_item(src, src2, K, Nsrc, dst, Ndst, mode, gain, scr, it, lane);
    }
}

template <int W> __device__ __forceinline__ void pool_rows_prompt(const Params& p, int layer, const float* xp, const LAS float* rst, int t0, int half, int c4, int g, f32x4 gn, bf16_t* Dbuf) {
    const int rfirst = t0 + half * 16, r0 = rfirst - (W - 1), bstart = t0 & ~(SEQ - 1);
    f32x4 u[W + 15];
    const float* xr = xp + (size_t)r0 * DM + c4;
#pragma unroll
    for (int k = 0; k < W + 15; ++k) { const int r = r0 + k; u[k] = (f32x4){0.f, 0.f, 0.f, 0.f}; if (r >= bstart) u[k] = *(const f32x4*)xr; xr += DM; asm volatile("" : "+v"(xr)); }
#pragma unroll
    for (int k = 0; k < W + 15; ++k) { const int r = r0 + k; if (r >= bstart) u[k] = u[k] * rst[r - (t0 - 15)] * gn; }
    f32x4 S = {0.f, 0.f, 0.f, 0.f};
#pragma unroll
    for (int k = 0; k < W - 1; ++k) S += u[k];
#pragma unroll
    for (int i = 0; i < 16; ++i) {
        const int r = rfirst + i; const f32x4 uu = u[W - 1 + i];
        S += uu;
        const int s1 = (r & (SEQ - 1)) + 1; const int cnt = s1 < W ? s1 : W;
        const f32x4 d = S * (1.0f / (float)cnt) - uu;
        u32x2 wv; wv.x = pk_bf16(d[0], d[1]); wv.y = pk_bf16(d[2], d[3]);
        *(u32x2*)(Dbuf + ((size_t)g * MT + r) * 256 + (c4 - 256 * g)) = wv;
        const int s = r & (SEQ - 1), b = r >> 12;
        if (s >= SEQ - 15) *(f32x4*)(p.out + O_PP + ((size_t)(b * 2 + layer) * 15 + (s - (SEQ - 15))) * DM + c4) = uu;
        S -= u[i];
    }
}
template <int W> __device__ __forceinline__ void pool_rows_sample(const Params& p, int layer, const float* xs, const LAS float* rst, int n, int half, int c4, int g, f32x4 gn, bf16_t* Dbuf) {
    const int e0 = 15 + 4 * half - (W - 1);
    const float* sp = p.state_pool + (size_t)(n * 2 + layer) * 15 * DM + c4;
    f32x4 u[W + 3];
#pragma unroll
    for (int k = 0; k < W + 3; ++k) { const int e = e0 + k; u[k] = (e < 15) ? *(const f32x4*)(sp + (size_t)e * DM) : *(const f32x4*)(xs + (size_t)(n * 8 + e - 15) * DM + c4) * rst[e - 15] * gn; }
    f32x4 S = {0.f, 0.f, 0.f, 0.f};
#pragma unroll
    for (int k = 0; k < W - 1; ++k) S += u[k];
    float* po = p.out + O_PS + (size_t)(n * 2 + layer) * 15 * DM + c4;
#pragma unroll
    for (int i = 0; i < 4; ++i) {
        const int t = 4 * half + i, r = MP + n * 8 + t; const f32x4 uu = u[W - 1 + i];
        S += uu;
        const f32x4 d = S * (1.0f / (float)W) - uu;
        u32x2 wv; wv.x = pk_bf16(d[0], d[1]); wv.y = pk_bf16(d[2], d[3]);
        *(u32x2*)(Dbuf + ((size_t)g * MT + r) * 256 + (c4 - 256 * g)) = wv;
        *(f32x4*)(po + (size_t)(7 + t) * DM) = uu;
        S -= u[i];
    }
    if (half == 0) {
#pragma unroll
        for (int k = 0; k < 7; ++k) *(f32x4*)(po + (size_t)k * DM) = *(const f32x4*)(sp + (size_t)(8 + k) * DM);
    }
}
__device__ __forceinline__ float row_ssq3(const float* r0, const float* r1, const float* r2, int lane, float& s1, float& s2) {
    f32x4 v[12];
#pragma unroll
    for (int j = 0; j < 4; ++j) { v[j] = *(const f32x4*)(r0 + 4 * lane + 256 * j); v[4 + j] = *(const f32x4*)(r1 + 4 * lane + 256 * j); v[8 + j] = *(const f32x4*)(r2 + 4 * lane + 256 * j); }
    float a = 0.f, b = 0.f, c = 0.f;
#pragma unroll
    for (int j = 0; j < 4; ++j) { a += (v[j][0] * v[j][0] + v[j][1] * v[j][1]) + (v[j][2] * v[j][2] + v[j][3] * v[j][3]);
        b += (v[4 + j][0] * v[4 + j][0] + v[4 + j][1] * v[4 + j][1]) + (v[4 + j][2] * v[4 + j][2] + v[4 + j][3] * v[4 + j][3]);
        c += (v[8 + j][0] * v[8 + j][0] + v[8 + j][1] * v[8 + j][1]) + (v[8 + j][2] * v[8 + j][2] + v[8 + j][3] * v[8 + j][3]); }
#pragma unroll
    for (int o = 1; o < 64; o <<= 1) { a += __shfl_xor(a, o); b += __shfl_xor(b, o); c += __shfl_xor(c, o); }
    s1 = b; s2 = c; return a;
}
__device__ __forceinline__ void pool_prep(const Params& p, int layer, LAS unsigned char* lds) {
    const int tid = opaque_tid(), lane = tid & 63, wave = tid >> 6;
    LAS float* rst = (LAS float*)(lds + 73728);
    const float* xp = layer == 0 ? p.x_prompt : p.out + O_YP;
    const float* xs = layer == 0 ? p.x_sample : p.out + O_YS;
    const float* gain = p.a_norm + layer * DM;
    bf16_t* Dbuf = (bf16_t*)(p.ws + WS_DBUF);
    const int c4 = (tid & 255) * 4, half = tid >> 8, g = (tid & 255) >> 6;
    const f32x4 gn = *(const f32x4*)(gain + c4);
    const int vblk = (gridDim.x & 7) == 0 ? (int)((blockIdx.x & 7) * (gridDim.x >> 3) + (blockIdx.x >> 3)) : (int)blockIdx.x;
    for (int it = vblk; it < MP / 32; it += gridDim.x) {
        {
            const int t0 = it * 32;
            const bool halo = (t0 & (SEQ - 1)) != 0;
#pragma unroll
            for (int bt = 0; bt < 2; ++bt) {
                int rr[3]; const float* rp[3];
#pragma unroll
                for (int q = 0; q < 3; ++q) { rr[q] = wave + 8 * (3 * bt + q); int r = t0 - 15 + rr[q]; const bool ok = rr[q] < 47 && (rr[q] >= 15 || halo); if (!ok) r = t0; rp[q] = xp + (size_t)r * DM; }
                float s1, s2; const float s0 = row_ssq3(rp[0], rp[1], rp[2], lane, s1, s2);
                if (lane == 0) { if (rr[0] < 47) rst[rr[0]] = 1.0f / sqrtf(s0 * (1.0f / DM) + EPS); if (rr[1] < 47) rst[rr[1]] = 1.0f / sqrtf(s1 * (1.0f / DM) + EPS); if (rr[2] < 47) rst[rr[2]] = 1.0f / sqrtf(s2 * (1.0f / DM) + EPS); }
            }
            __syncthreads();
            if (g == 0) pool_rows_prompt<2>(p, layer, xp, rst, t0, half, c4, g, gn, Dbuf);
            else if (g == 1) pool_rows_prompt<4>(p, layer, xp, rst, t0, half, c4, g, gn, Dbuf);
            else if (g == 2) pool_rows_prompt<8>(p, layer, xp, rst, t0, half, c4, g, gn, Dbuf);
            else pool_rows_prompt<16>(p, layer, xp, rst, t0, half, c4, g, gn, Dbuf);
        }
        __syncthreads();
    }
    for (int it = gridDim.x - 1 - blockIdx.x; it < 32; it += gridDim.x) {
        {
            const int n = it;
            { const float* row = xs + (size_t)(n * 8 + wave) * DM; float ss = 0.f;
#pragma unroll
              for (int j = 0; j < 4; ++j) { const f32x4 v = *(const f32x4*)(row + 4 * lane + 256 * j); ss += (v[0] * v[0] + v[1] * v[1]) + (v[2] * v[2] + v[3] * v[3]); }
#pragma unroll
              for (int o = 1; o < 64; o <<= 1) ss += __shfl_xor(ss, o);
              if (lane == 0) rst[wave] = 1.0f / sqrtf(ss * (1.0f / DM) + EPS); }
            __syncthreads();
            if (g == 0) pool_rows_sample<2>(p, layer, xs, rst, n, half, c4, g, gn, Dbuf);
            else if (g == 1) pool_rows_sample<4>(p, layer, xs, rst, n, half, c4, g, gn, Dbuf);
            else if (g == 2) pool_rows_sample<8>(p, layer, xs, rst, n, half, c4, g, gn, Dbuf);
            else pool_rows_sample<16>(p, layer, xs, rst, n, half, c4, g, gn, Dbuf);
        }
        __syncthreads();
    }
}

__device__ __forceinline__ void phase_prep(const Params& p, LAS unsigned char* lds) {
    const int tid = opaque_tid(), lane = tid & 63, wave = tid >> 6;
    const int gw = blockIdx.x * NWAVES + wave, NGW = gridDim.x * NWAVES;
    const size_t gt = (size_t)blockIdx.x * NTHREADS + tid, NGT = (size_t)gridDim.x * NTHREADS;
    prep_weights(p, lds, gw, NGW, wave, lane);
    { float* ssq = (float*)(p.ws + WS_SSQ); for (size_t i = gt; i < (size_t)8 * MT; i += NGT) ssq[i] = 0.f; }
    { float* rc = (float*)(p.ws + WS_ROPE); float* rs = rc + 4104 * 32;
      for (size_t i = gt; i < (size_t)4104 * 32; i += NGT) { const int pi = (int)(i >> 5), f = (int)(i & 31); const int pos = pi < SEQ ? pi : 8192 + (pi - SEQ);
          const double turns = (double)pos * INV_FREQ[f] * 0.15915494309189535; const double fr = turns - floor(turns);
          const float a = (float)(fr * 6.283185307179586); rc[i] = __builtin_amdgcn_cosf((float)fr); rs[i] = __builtin_amdgcn_sinf((float)fr); } }
    pool_prep(p, 0, lds);
}

__device__ __forceinline__ void phase_merge(const Params& p) {
    const bf16_t* OG = (const bf16_t*)(p.ws + WS_OG); const float* LSE = (const float*)(p.ws + WS_LSE); bf16_t* OB = (bf16_t*)(p.ws + WS_OB);
    const size_t gt = (size_t)blockIdx.x * NTHREADS + opaque_tid(), NGT = (size_t)gridDim.x * NTHREADS;
    for (size_t i = gt; i < (size_t)MP * 128; i += NGT) {
        const size_t row = i >> 7; const int ch = (int)(i & 127), h = ch >> 3;
        const float l0 = LSE[(0 * (size_t)MP + row) * 16 + h], l1 = LSE[(1 * (size_t)MP + row) * 16 + h], l2 = LSE[(2 * (size_t)MP + row) * 16 + h];
        const float mx = fmaxf(l0, fmaxf(l1, l2));
        float w0 = __builtin_amdgcn_exp2f(l0 - mx), w1 = __builtin_amdgcn_exp2f(l1 - mx), w2 = __builtin_amdgcn_exp2f(l2 - mx);
        const float inv = 1.0f / (w0 + w1 + w2); w0 *= inv; w1 *= inv; w2 *= inv;
        const u32x4 a = *(const u32x4*)(OG + (0 * (size_t)MP + row) * DM + ch * 8), b = *(const u32x4*)(OG + (1 * (size_t)MP + row) * DM + ch * 8), c = *(const u32x4*)(OG + (2 * (size_t)MP + row) * DM + ch * 8);
        u32x4 o;
#pragma unroll
        for (int e = 0; e < 4; ++e) {
            const float lo = w0 * __uint_as_float(a[e] << 16) + w1 * __uint_as_float(b[e] << 16) + w2 * __uint_as_float(c[e] << 16);
            const float hi = w0 * __uint_as_float(a[e] & 0xffff0000u) + w1 * __uint_as_float(b[e] & 0xffff0000u) + w2 * __uint_as_float(c[e] & 0xffff0000u);
            o[e] = pk_bf16(lo, hi);
        }
        *(u32x4*)(OB + row * DM + ch * 8) = o;
    }
}

struct AttnGeom { int dil, r, c, rL; size_t base, lbase, hbase; };
__device__ __forceinline__ AttnGeom attn_geom(int u) {
    const int j5 = (u >> 3) & 31, rc = j5 & 15, h = 2 * (u & 7) + (j5 >> 4), b = (u >> 8) & 3, g = u >> 10;
    AttnGeom G; G.dil = 1 << (2 * g); G.r = rc & (G.dil - 1); G.c = rc >> (2 * g); G.rL = G.r << (12 - 2 * g);
    G.base = ((size_t)g * MP + (size_t)b * SEQ) * DM + h * 64; G.lbase = ((size_t)g * MP + (size_t)b * SEQ) * 16 + h;
    G.hbase = (size_t)((g * 4 + b) * 16 + h) * SEQ * 64; return G;
}
__device__ __forceinline__ void attn_load(const Params& p, int u, int tid, u32x4 (&kreg)[6], u32x4 (&vreg)[6]) {
    const AttnGeom G = attn_geom(u);
    const bf16_t* Kg = (const bf16_t*)(p.ws + WS_KB) + G.hbase; const bf16_t* Vg = (const bf16_t*)(p.ws + WS_VB) + G.hbase;
    const int ch = tid & 7;
#pragma unroll
    for (int k = 0; k < 6; ++k) {
        const int i = (tid >> 3) + 64 * k, kl = 256 * G.c - 128 + i;
        u32x4 kv = {0u, 0u, 0u, 0u}, vv = {0u, 0u, 0u, 0u};
        if (kl >= 0) { const size_t ro = (size_t)(G.rL + kl) * 64 + ch * 8; kv = *(const u32x4*)(Kg + ro); vv = *(const u32x4*)(Vg + ro); }
        kreg[k] = kv; vreg[k] = vv;
    }
}
__device__ __forceinline__ void attn_load_q(const Params& p, int u, int tid, bf16x8 (&qf)[4]) {
    const AttnGeom G = attn_geom(u);
    const bf16_t* Qg = (const bf16_t*)(p.ws + WS_QB) + G.hbase;
    const int lane = tid & 63, wave = tid >> 6, qi = lane & 31, hi = lane >> 5;
    const size_t qro = (size_t)(G.rL + 256 * G.c + 32 * wave + qi) * 64;
#pragma unroll
    for (int d0 = 0; d0 < 4; ++d0) qf[d0] = *(const bf16x8*)(Qg + qro + d0 * 16 + hi * 8);
}
__device__ __forceinline__ void attn_stage(int tid, LAS unsigned char* lds, const u32x4 (&kreg)[6], const u32x4 (&vreg)[6]) {
    const int ch = tid & 7;
#pragma unroll
    for (int k = 0; k < 6; ++k) {
        const int i = (tid >> 3) + 64 * k;
        *(LAS u32x4*)(lds + i * 128 + ((ch ^ ((i >> 1) & 7)) << 4)) = kreg[k];
        *(LAS u32x4*)(lds + 49152 + i * 128 + ((ch ^ (((i >> 1) & 1) << 2)) << 4)) = vreg[k];
    }
}
__device__ __forceinline__ int crow(int r, int hi) { return (r & 3) + 8 * (r >> 2) + 4 * hi; }
__device__ __forceinline__ void attn_compute(const Params& p, int u, int tid, LAS unsigned char* lds, const bf16x8 (&qf)[4]) {
    const int lane = tid & 63, wave = __builtin_amdgcn_readfirstlane(tid >> 6);
    const AttnGeom G = attn_geom(u);
    const int c = G.c;
    bf16_t* Og = (bf16_t*)(p.ws + WS_OG) + G.base; float* Lg = (float*)(p.ws + WS_LSE) + G.lbase;
    LAS unsigned char* ldsK = lds; LAS unsigned char* ldsV = lds + 49152;
    const int qi = lane & 31, hi = lane >> 5;
    const size_t posq = (size_t)(G.r + G.dil * (256 * c + 32 * wave + qi));
    f32x16 o0, o1;
#pragma unroll
    for (int e = 0; e < 16; ++e) { o0[e] = 0.f; o1[e] = 0.f; }
    float mrun = -1e30f, lrun = 0.f;
    const int jstart = (c == 0 && wave < 4) ? 4 - wave : 0;
    for (int jt = jstart; jt < 5; ++jt) {
        const int rowb = 32 * (wave + jt), krow = rowb + qi;
        f32x16 s;
#pragma unroll
        for (int e = 0; e < 16; ++e) s[e] = 0.f;
#pragma unroll
        for (int d0 = 0; d0 < 4; ++d0) { const int ch = 2 * d0 + hi;
            const bf16x8 kf = *(const LAS bf16x8*)(ldsK + krow * 128 + ((ch ^ ((krow >> 1) & 7)) << 4));
            s = __builtin_amdgcn_mfma_f32_32x32x16_bf16(kf, qf[d0], s, 0, 0, 0); }
        if (jt == 0) {
#pragma unroll
            for (int e = 0; e < 16; ++e) if (crow(e, hi) < qi) s[e] = -1e30f;
        }
        if (jt == 4) {
#pragma unroll
            for (int e = 0; e < 16; ++e) if (crow(e, hi) > qi) s[e] = -1e30f;
        }
        float mx = s[0];
#pragma unroll
        for (int e = 1; e < 16; ++e) mx = fmaxf(mx, s[e]);
        mx = fmaxf(mx, __shfl_xor(mx, 32));
        const float mnew = fmaxf(mrun, mx), alpha = __builtin_amdgcn_exp2f(mrun - mnew);
        float ls = 0.f;
#pragma unroll
        for (int e = 0; e < 16; ++e) { s[e] = __builtin_amdgcn_exp2f(s[e] - mnew); ls += s[e]; }
        lrun = lrun * alpha + ls; mrun = mnew;
#pragma unroll
        for (int e = 0; e < 16; ++e) { o0[e] *= alpha; o1[e] *= alpha; }
#pragma unroll
        for (int ks = 0; ks < 2; ++ks) {
            u32x4 pw; pw.x = pk_bf16(s[8 * ks + 0], s[8 * ks + 1]); pw.y = pk_bf16(s[8 * ks + 2], s[8 * ks + 3]); pw.z = pk_bf16(s[8 * ks + 4], s[8 * ks + 5]); pw.w = pk_bf16(s[8 * ks + 6], s[8 * ks + 7]);
            const bf16x8 pf = __builtin_bit_cast(bf16x8, pw);
            const int vrow = rowb + 16 * ks + 4 * hi + ((lane & 15) >> 2);
#pragma unroll
            for (int d0 = 0; d0 < 2; ++d0) {
                const int chv = 4 * d0 + 2 * ((lane >> 4) & 1) + ((lane & 3) >> 1);
                LAS unsigned char* a1 = ldsV + vrow * 128 + ((chv ^ (((vrow >> 1) & 1) << 2)) << 4) + 8 * (lane & 1);
                const s16x4 lo = __builtin_bit_cast(s16x4, __builtin_amdgcn_ds_read_tr16_b64_v4i16((LAS s16x4*)a1));
                const s16x4 hi4 = __builtin_bit_cast(s16x4, __builtin_amdgcn_ds_read_tr16_b64_v4i16((LAS s16x4*)(a1 + 8 * 128)));
                const bf16x8 vf = {lo[0], lo[1], lo[2], lo[3], hi4[0], hi4[1], hi4[2], hi4[3]};
                if (d0 == 0) o0 = __builtin_amdgcn_mfma_f32_32x32x16_bf16(vf, pf, o0, 0, 0, 0);
                else o1 = __builtin_amdgcn_mfma_f32_32x32x16_bf16(vf, pf, o1, 0, 0, 0);
            }
        }
    }
    lrun += __shfl_xor(lrun, 32);
    const float inv = 1.0f / lrun;
    LAS unsigned char* stg = lds + 98304 + wave * 4096;
#pragma unroll
    for (int a = 0; a < 4; ++a) {
        u32x2 w0, w1;
        w0.x = pk_bf16(o0[4 * a] * inv, o0[4 * a + 1] * inv); w0.y = pk_bf16(o0[4 * a + 2] * inv, o0[4 * a + 3] * inv);
        w1.x = pk_bf16(o1[4 * a] * inv, o1[4 * a + 1] * inv); w1.y = pk_bf16(o1[4 * a + 2] * inv, o1[4 * a + 3] * inv);
        *(LAS u32x2*)(stg + qi * 128 + (((a) ^ (qi & 7)) << 4) + 8 * hi) = w0;
        *(LAS u32x2*)(stg + qi * 128 + (((4 + a) ^ (qi & 7)) << 4) + 8 * hi) = w1;
    }
    asm volatile("s_waitcnt lgkmcnt(0)" ::: "memory");
#pragma unroll
    for (int i = 0; i < 4; ++i) {
        const int row = i * 8 + (lane >> 3), ch = lane & 7;
        const u32x4 v = *(const LAS u32x4*)(stg + row * 128 + ((ch ^ (row & 7)) << 4));
        const size_t pr = (size_t)(G.r + G.dil * (256 * c + 32 * wave + row));
        *(u32x4*)(Og + pr * DM + ch * 8) = v;
    }
    if (hi == 0) Lg[posq * 16] = mrun + __builtin_amdgcn_logf(lrun);
}

__device__ __forceinline__ f32x4 bf4_to_f32(u32x2 w) { f32x4 r; r[0] = __uint_as_float(w.x << 16); r[1] = __uint_as_float(w.x & 0xffff0000u); r[2] = __uint_as_float(w.y << 16); r[3] = __uint_as_float(w.y & 0xffff0000u); return r; }
struct SampState { float m, l; f32x4 o; };
__device__ __forceinline__ void sample_load(const Params& p, int u, int bi, int tid, u32x2 (&kk)[11], u32x2 (&vv)[11], f32x4& q4) {
    const int lane = tid & 63, t = tid >> 6, n = u >> 4, h = u & 15, kq = lane >> 4, dq = lane & 15, g = bi / 3, ci = bi - 3 * g;
    const int hist = 128 << (2 * g), dil = 1 << (2 * g);
    const bf16_t* CK = (const bf16_t*)(p.ws + WS_CK); const bf16_t* CV = (const bf16_t*)(p.ws + WS_CV);
    const size_t cb = pg8::ckv_off(g, n, h, 0) + 4 * dq;
    q4 = *(const f32x4*)((const float*)(p.ws + WS_QS) + (size_t)(n * 8 + t) * 3072 + (g * 16 + h) * 64 + 4 * dq);
#pragma unroll
    for (int i = 0; i < 11; ++i) {
        const int j = 4 * (11 * ci + i) + kq, jc = j <= 128 ? j : 128;
        const int idxc = g == 2 ? (128 - jc) * 8 + t : hist + t - dil * jc;
        kk[i] = *(const u32x2*)(CK + cb + (size_t)idxc * 64); vv[i] = *(const u32x2*)(CV + cb + (size_t)idxc * 64);
    }
}
__device__ __forceinline__ void sample_math(int bi, int tid, const u32x2 (&kk)[11], const u32x2 (&vv)[11], const f32x4 q4, SampState& S) {
    const int kq = (tid & 63) >> 4, ci = bi % 3;
    float m = S.m, l = S.l; f32x4 o = S.o;
#pragma unroll
    for (int i = 0; i < 11; ++i) {
        const int j = 4 * (11 * ci + i) + kq;
        const f32x4 k4 = bf4_to_f32(kk[i]), v4 = bf4_to_f32(vv[i]);
        float s = (q4[0] * k4[0] + q4[1] * k4[1]) + (q4[2] * k4[2] + q4[3] * k4[3]);
        s += __shfl_xor(s, 1); s += __shfl_xor(s, 2); s += __shfl_xor(s, 4); s += __shfl_xor(s, 8);
        if (j > 128) s = -1e30f;
        const float mnew = fmaxf(m, s), alpha = __builtin_amdgcn_exp2f(m - mnew), pp = __builtin_amdgcn_exp2f(s - mnew);
        l = l * alpha + pp; o = o * alpha + v4 * pp; m = mnew;
    }
    S.m = m; S.l = l; S.o = o;
}
__device__ __forceinline__ void sample_finish(const Params& p, int u, int tid, SampState& S) {
    const int lane = tid & 63, t = tid >> 6, n = u >> 4, h = u & 15, kq = lane >> 4, dq = lane & 15;
    float m = S.m, l = S.l; f32x4 o = S.o;
    float M = fmaxf(m, __shfl_xor(m, 16)); M = fmaxf(M, __shfl_xor(M, 32));
    const float f = __builtin_amdgcn_exp2f(m - M); l *= f; o = o * f;
    l += __shfl_xor(l, 16); l += __shfl_xor(l, 32);
#pragma unroll
    for (int e = 0; e < 4; ++e) { float x = o[e]; x += __shfl_xor(x, 16); x += __shfl_xor(x, 32); o[e] = x; }
    if (kq == 0) { const float inv = 1.0f / l; u32x2 w; w.x = pk_bf16(o[0] * inv, o[1] * inv); w.y = pk_bf16(o[2] * inv, o[3] * inv);
        *(u32x2*)((bf16_t*)(p.ws + WS_OB) + (size_t)(MP + n * 8 + t) * DM + h * 64 + 4 * dq) = w; }
    S.m = -1e30f; S.l = 0.f; S.o = (f32x4){0.f, 0.f, 0.f, 0.f};
}
__device__ __forceinline__ void phase_attn(const Params& p, LAS unsigned char* lds, int dup) {
    const int tid = opaque_tid();
    int su = blockIdx.x, sb = 0;
    SampState S; S.m = -1e30f; S.l = 0.f; S.o = (f32x4){0.f, 0.f, 0.f, 0.f};
    int u = blockIdx.x;
    u32x4 kreg[6], vreg[6]; bf16x8 qf[4];
    if (u < 3072) { attn_load(p, u, tid, kreg, vreg); attn_load_q(p, u, tid, qf); }
    for (; u < 3072; u += gridDim.x) {
        attn_stage(tid, lds, kreg, vreg);
        __syncthreads();
        const bool hs = su < 512;
        u32x2 kk[11], vv[11]; f32x4 q4;
        if (hs) sample_load(p, su, sb, tid, kk, vv, q4);
        const int un = u + gridDim.x;
        if (un < 3072) attn_load(p, un, tid, kreg, vreg);
        attn_compute(p, u, tid, lds, qf);
        if (un < 3072) attn_load_q(p, un, tid, qf);
        if (hs) { sample_math(sb, tid, kk, vv, q4, S); if (++sb == 9) { sample_finish(p, su, tid, S); sb = 0; su += gridDim.x; } }
        __syncthreads();
    }
    if (su < 512) {
        u32x2 ka[11], va[11], kb[11], vb[11]; f32x4 qa, qb;
        sample_load(p, su, sb, tid, ka, va, qa);
        for (;;) {
            int su2 = su, sb2 = sb + 1; if (sb2 == 9) { sb2 = 0; su2 += gridDim.x; }
            const bool more = su2 < 512;
            if (more) sample_load(p, su2, sb2, tid, kb, vb, qb);
            sample_math(sb, tid, ka, va, qa, S); if (sb == 8) sample_finish(p, su, tid, S);
            if (!more) break;
            su = su2; sb = sb2;
            su2 = su; sb2 = sb + 1; if (sb2 == 9) { sb2 = 0; su2 += gridDim.x; }
            const bool more2 = su2 < 512;
            if (more2) sample_load(p, su2, sb2, tid, ka, va, qa);
            sample_math(sb, tid, kb, vb, qb, S); if (sb == 8) sample_finish(p, su, tid, S);
            if (!more2) break;
            su = su2; sb = sb2;
        }
    }
}

constexpr int NTASK_A = 32 * (16 + 64 + 128), NTASK = NTASK_A + 32 * 128;
struct ChunkGeom { int g, n, R0, hist; };
__device__ __forceinline__ ChunkGeom chunk_geom(int it) {
    ChunkGeom C; int ck;
    if (it < 32 * 16) { C.g = 0; C.n = it >> 4; ck = it & 15; }
    else if (it < 32 * (16 + 64)) { const int r = it - 32 * 16; C.g = 1; C.n = r >> 6; ck = r & 63; }
    else if (it < NTASK_A) { const int r = it - 32 * (16 + 64); C.g = 2; C.n = r >> 7; ck = 2 * (r & 127); }
    else { const int r = it - NTASK_A; C.g = 2; C.n = r >> 7; ck = 2 * (r & 127) + 1; }
    C.hist = 128 << (2 * C.g); C.R0 = 8 * ck; return C;
}
__device__ __forceinline__ void chunk_load(const Params& p, int it, int tid, f32x4 (&v)[8]) {
    const ChunkGeom C = chunk_geom(it);
    const float* cache = C.g == 0 ? p.cache0 : (C.g == 1 ? p.cache1 : p.cache2);
    const f32x4* src = (const f32x4*)(cache + ((size_t)C.n * C.hist + C.R0) * 2048) + tid;
#pragma unroll
    for (int k = 0; k < 8; ++k) v[k] = __builtin_nontemporal_load(src + k * 512);
}
__device__ __forceinline__ void chunk_store(const Params& p, int it, int tid, const f32x4 (&v)[8]) {
    const ChunkGeom C = chunk_geom(it);
    if (C.R0 >= 8) {
        f32x4* dst = (f32x4*)(p.out + (C.g == 0 ? O_KS0 : (C.g == 1 ? O_KS1 : O_KS2)) + ((size_t)C.n * C.hist + C.R0 - 8) * 2048) + tid;
#pragma unroll
        for (int k = 0; k < 8; ++k) __builtin_nontemporal_store(v[k], dst + k * 512);
    }
    if (it < NTASK_A) {
        const int kv = tid >> 8, h = (tid >> 4) & 15, d4 = tid & 15;
        const int idxc0 = C.g == 2 ? (C.R0 >> 4) * 8 : C.R0;
        bf16_t* cp = (bf16_t*)(p.ws + (kv ? WS_CV : WS_CK)) + pg8::ckv_off(C.g, C.n, h, idxc0) + 4 * d4;
#pragma unroll
        for (int k = 0; k < 8; ++k) { u32x2 w; w.x = pk_bf16(v[k][0], v[k][1]); w.y = pk_bf16(v[k][2], v[k][3]); *(u32x2*)(cp + k * 64) = w; }
    }
}
__device__ __forceinline__ void steal_work(const Params& p, LAS unsigned char* lds, int k, unsigned mand) {
    unsigned* ctl = (unsigned*)(p.ws + WS_CTL);
    const int tid = opaque_tid();
    LAS int* flag = (LAS int*)lds;
    __syncthreads();
    if (k >= 0 && tid == 0) atomicAdd(ctl + 64 + 16 * k, 1u);
    for (;;) {
        if (tid == 0) {
            int t0 = -1, t1 = -1; bool go = true, forced = k < 0;
            if (k >= 0) go = __hip_atomic_load(ctl + 64 + 16 * k, __ATOMIC_RELAXED, __HIP_MEMORY_SCOPE_AGENT) < gridDim.x;
            if (!go && mand) { go = __hip_atomic_load(ctl, __ATOMIC_RELAXED, __HIP_MEMORY_SCOPE_AGENT) < mand; forced = go; }
            if (go) { const unsigned nt = forced ? 2u : 1u; const unsigned tk = atomicAdd(ctl, nt); if (tk < (unsigned)NTASK) t0 = (int)tk; if (nt == 2u && tk + 1u < (unsigned)NTASK) t1 = (int)(tk + 1u); }
            flag[0] = t0; flag[1] = t1;
        }
        __syncthreads();
        const int t0 = flag[0], t1 = flag[1];
        __syncthreads();
        if (t0 < 0) break;
        f32x4 va[8];
        chunk_load(p, t0, tid, va);
        if (t1 >= 0) { f32x4 vb[8]; chunk_load(p, t1, tid, vb); chunk_store(p, t0, tid, va); chunk_store(p, t1, tid, vb); }
        else chunk_store(p, t0, tid, va);
    }
}

#define XB_TMO      128
#define XB_XCNT(j)  (256  + 64 * (j))
#define XB_XSUB(j)  (1280 + 64 * (j))
#define XB_XGEN(j)  (2304 + 64 * (j))
#define XB_TOP      3328
#define XB_TOPGEN   3392
#define XCD_BAR_WORDS 3456
#define XB_SPIN_CAP (1u << 18)

__device__ __forceinline__ unsigned xb_ld(unsigned* p)              { return __hip_atomic_load(p, __ATOMIC_RELAXED, __HIP_MEMORY_SCOPE_AGENT); }
__device__ __forceinline__ unsigned xb_add(unsigned* p, unsigned v) { return __hip_atomic_fetch_add(p, v, __ATOMIC_RELAXED, __HIP_MEMORY_SCOPE_AGENT); }
__device__ __forceinline__ unsigned xb_xcc_id() { return (unsigned)__builtin_amdgcn_s_getreg((3 << 11) | 20) & 0xFu; }
#define XB_SPIN(cond, bar) do { unsigned _sp = 0; while (cond) { __builtin_amdgcn_s_sleep(1); \
    if ((++_sp & 255u) == 0u) { if (xb_ld(&(bar)[XB_TMO])) break; if (_sp > XB_SPIN_CAP) { atomicAdd(&(bar)[XB_TMO], 1u); break; } } } } while (0)

struct XcdBarrier {
    unsigned* bar; unsigned x;
    volatile LAS unsigned* st;
};

__device__ __forceinline__ XcdBarrier xcd_barrier_post(unsigned* bar, volatile LAS unsigned* st) {
    XcdBarrier b; b.bar = bar; b.x = xb_xcc_id(); b.st = st;
    if (threadIdx.x == 0) (void)xb_add(&bar[XB_XCNT(b.x)], 1u);
    return b;
}
__device__ __forceinline__ void xcd_barrier_complete(unsigned* bar, unsigned x, unsigned& nloc, unsigned& nx) {
    const unsigned G = gridDim.x * gridDim.y * gridDim.z;
    unsigned sum, cnt, mine, sp = 0u;
    for (;;) {
        sum = 0u; cnt = 0u; mine = 0u;
#pragma unroll
        for (unsigned j = 0; j < 16; ++j) { const unsigned c = xb_ld(&bar[XB_XCNT(j)]); sum += c; cnt += (c > 0u) ? 1u : 0u; mine = (j == x) ? c : mine; }
        if (sum == G) break;
        __builtin_amdgcn_s_sleep(1);
        if ((++sp & 255u) == 0u) { if (xb_ld(&bar[XB_TMO])) break; if (sp > XB_SPIN_CAP) { atomicAdd(&bar[XB_TMO], 1u); break; } }
    }
    nloc = mine > 0u ? mine : 1u; nx = cnt > 0u ? cnt : 1u;
}

__device__ __forceinline__ void xcd_barrier(const XcdBarrier& b) {
    asm volatile("s_waitcnt vmcnt(0)" ::: "memory");
    __syncthreads();
    if (threadIdx.x == 0) {
        unsigned* bar = b.bar;
        __builtin_amdgcn_s_waitcnt(0);
        unsigned nloc = b.st[0], nx = b.st[1];
        if (nloc == 0u) { xcd_barrier_complete(bar, b.x, nloc, nx); b.st[0] = nloc; b.st[1] = nx; }
        const unsigned old = xb_add(&bar[XB_XSUB(b.x)], 1u);
        const unsigned gen = old / nloc;
        if (old + 1u == (gen + 1u) * nloc) {
            __builtin_amdgcn_fence(__ATOMIC_RELEASE, "agent");
            asm volatile("s_waitcnt vmcnt(0)" ::: "memory");
            const unsigned og = xb_add(&bar[XB_TOP], 1u);
            const unsigned tg = og / nx;
            if (og + 1u == (tg + 1u) * nx) xb_add(&bar[XB_TOPGEN], 1u);
            else XB_SPIN(xb_ld(&bar[XB_TOPGEN]) == tg, bar);
            __builtin_amdgcn_fence(__ATOMIC_ACQUIRE, "agent");
            xb_add(&bar[XB_XGEN(b.x)], 1u);
            asm volatile("s_waitcnt vmcnt(0)" ::: "memory");
        } else {
            XB_SPIN(xb_ld(&bar[XB_XGEN(b.x)]) == gen, bar);
            __builtin_amdgcn_fence(__ATOMIC_ACQUIRE, "agent");
            asm volatile("s_waitcnt vmcnt(0)" ::: "memory");
        }
    }
    __syncthreads();
}

__device__ __forceinline__ void seam_barrier(const Params& p, int k) {
    unsigned* w = (unsigned*)(p.ws + WS_CTL) + 3072 + 16 * k;
    __syncthreads();
    if (opaque_tid() == 0) {
        __builtin_amdgcn_fence(__ATOMIC_RELEASE, "agent");
        asm volatile("s_waitcnt vmcnt(0)" ::: "memory");
        __hip_atomic_fetch_add(w, 1u, __ATOMIC_RELAXED, __HIP_MEMORY_SCOPE_AGENT);
        unsigned spins = 0;
        while (__hip_atomic_load(w, __ATOMIC_RELAXED, __HIP_MEMORY_SCOPE_AGENT) < gridDim.x) { __builtin_amdgcn_s_sleep(1); if (++spins > (1u << 24)) break; }
        __builtin_amdgcn_fence(__ATOMIC_ACQUIRE, "agent");
        asm volatile("s_waitcnt vmcnt(0)" ::: "memory");
    }
    __syncthreads();
}

constexpr int NSTEPS = 20;
#ifndef PROBE_DUP_MASK
#define PROBE_DUP_MASK 0u
#endif
__global__ void __launch_bounds__(NTHREADS, 2) yoco_fwd(Params p) {
    extern __shared__ __attribute__((aligned(16))) unsigned char lds_raw[];
    LAS unsigned char* lds = (LAS unsigned char*)lds_raw;
    cg::grid_group grid = cg::this_grid();
    volatile LAS unsigned* xst = (volatile LAS unsigned*)(lds + 131072 + 64);
    if (threadIdx.x == 0) { xst[0] = 0u; xst[1] = 0u; }
    __syncthreads();
    const XcdBarrier xbar = xcd_barrier_post((unsigned*)(p.ws + WS_CTL) + 4096, xst);
    grid.sync();
    unsigned char* ws = p.ws;
    float* X = p.out + O_YP;
    bf16_t* XB = (bf16_t*)(ws + WS_XB); bf16_t* H = (bf16_t*)(ws + WS_H); float* SSQ = (float*)(ws + WS_SSQ);
    const float* ropec = (const float*)(ws + WS_ROPE); const float* ropes = ropec + 4104 * 32;
    const int G = gridDim.x, c = blockIdx.x;
#pragma unroll 1
    for (int st2 = 2 * p.lo; st2 < 2 * p.hi; ++st2) {
        const int st = st2 >> 1;
        if ((st2 & 1) && !((PROBE_DUP_MASK >> st) & 1u)) continue;
        int kind, layer = 0, ssq_in = 0, ssq_out = -1;
        switch (st) {
            case 0: kind = 0; break;
            case 1: kind = 1; layer = 0; ssq_out = 0; break;
            case 2: kind = 2; layer = 0; ssq_in = 0; break;
            case 3: kind = 3; layer = 0; break;
            case 4: kind = 4; break;
            case 5: kind = 1; layer = 1; ssq_out = 1; break;
            case 6: kind = 2; layer = 1; ssq_in = 1; break;
            case 7: kind = 3; layer = 1; ssq_out = 2; break;
            case 8: kind = 5; ssq_in = 2; break;
            case 9: kind = 6; break;
            case 10: kind = 7; break;
            case 11: kind = 8; layer = 0; ssq_out = 3; break;
            case 12: kind = 2; layer = 2; ssq_in = 3; break;
            case 13: kind = 3; layer = 2; ssq_out = 4; break;
            case 14: kind = 9; ssq_in = 4; break;
            case 15: kind = 6; break;
            case 16: kind = 7; break;
            case 17: kind = 8; layer = 1; ssq_out = 5; break;
            case 18: kind = 2; layer = 3; ssq_in = 5; break;
            default: kind = 3; layer = 3; break;
        }
#ifdef PROBE_EMPTY_DUP
        if (st2 & 1) kind = -1;
#endif
        if (kind < 0) {}
        else if (kind == 0) phase_prep(p, lds);
        else if (kind == 4) pool_prep(p, 1, lds);
        else if (kind == 6) phase_attn(p, lds, st2 & 1);
        else if (kind == 7) phase_merge(p);
        else if (kind == 2) {
            unsigned* scnt = (unsigned*)(ws + WS_CTL) + 2048 + 16 * layer;
            if (c < G - 8) {
                pg8::Gemm g{XB, (const bf16_t*)(ws + WS_WGU) + (size_t)layer * 2 * FF * DM, MT, 2 * FF, DM};
                pg8::StaticOrder S; S.init(MP, 2 * FF, G - 8, c, 3); S.cnt = scnt;
                pg8::EpiGU E{SSQ + (size_t)ssq_in * MT, H};
                pg8::gemm_phase<pg8::EpiGU, pg8::StaticOrder, true, true>(lds, g, S, E);
            } else if (c < G - 4) {
                if (opaque_tid() == 0) { while (__hip_atomic_load(scnt, __ATOMIC_RELAXED, __HIP_MEMORY_SCOPE_AGENT) < 22u) __builtin_amdgcn_s_sleep(32); }
                __syncthreads();
                __builtin_amdgcn_fence(__ATOMIC_ACQUIRE, "agent");
                const int so = layer == 1 ? 2 : (layer == 2 ? 4 : -1);
                pg8::Gemm g{H, (const bf16_t*)(ws + WS_WDN) + (size_t)layer * DM * FF, MT, DM, FF};
                pg8::StaticOrder S; S.init(MP, DM, G, c - (G - 8), 4);
                pg8::EpiResid E; E.X = X; E.scale = nullptr; E.xin_p = X; E.xin_s = X + (size_t)MP * DM;
                E.xb = so >= 0 ? XB : nullptr; E.ssq = so >= 0 ? SSQ + (size_t)so * MT : nullptr;
                pg8::gemm_phase<pg8::EpiResid, pg8::StaticOrder, true, true>(lds, g, S, E);
            }
        } else if (kind == 5 || kind == 9) {
            pg8::Gemm g{XB, (const bf16_t*)(ws + (kind == 5 ? WS_WKVQ : WS_WQ1)), MT, kind == 5 ? 9216 : 3072, DM};
            pg8::StaticOrder S; S.init(MT, g.N, G, c, 0);
            pg8::EpiQKV E{SSQ + (size_t)ssq_in * MT, kind == 5 ? 0 : 24, p.k_norm, p.q_norm + (kind == 5 ? 0 : 192), ropec, ropes,
                          (bf16_t*)(ws + WS_KB), (bf16_t*)(ws + WS_VB), (bf16_t*)(ws + WS_QB), (float*)(ws + WS_QS), p.out, (bf16_t*)(ws + WS_CK), (bf16_t*)(ws + WS_CV)};
            pg8::gemm_phase<pg8::EpiQKV, pg8::StaticOrder, true, true>(lds, g, S, E);
        } else {
            pg8::Gemm g; pg8::StaticOrder S; pg8::EpiResid E;
            E.X = X; E.scale = nullptr; E.xin_p = X; E.xin_s = X + (size_t)MP * DM;
            E.xb = ssq_out >= 0 ? XB : nullptr; E.ssq = ssq_out >= 0 ? SSQ + (size_t)ssq_out * MT : nullptr;
            if (kind == 1) {
                g = pg8::Gemm{(const bf16_t*)(ws + WS_DBUF), (const bf16_t*)(ws + WS_WPOOL) + (size_t)layer * 4 * 65536, 4 * MT, 1024, 256};
                S.init(MT, 1024, G, c, 1); E.scale = p.pool_scale + layer * DM;
                if (layer == 0) { E.xin_p = p.x_prompt; E.xin_s = p.x_sample; }
            } else if (kind == 3) {
                g = pg8::Gemm{H, (const bf16_t*)(ws + WS_WDN) + (size_t)layer * DM * FF, MP, DM, FF};
                S.init(MP, DM, G, c, 0);
            } else {
                g = pg8::Gemm{(const bf16_t*)(ws + WS_OB), (const bf16_t*)(ws + WS_WO) + (size_t)layer * DM * DM, MT, DM, DM};
                S.init(MT, DM, G, c, 0);
            }
            pg8::gemm_phase<pg8::EpiResid, pg8::StaticOrder, true, true>(lds, g, S, E);
        }
        if (st2 + 2 < 2 * p.hi) {
            if (kind == 1 || kind == 2 || kind == 5 || kind == 8 || kind == 9) steal_work(p, lds, st2, st == 8 ? (unsigned)NTASK_A : 0u);
            xcd_barrier(xbar);
        }
    }
    steal_work(p, lds, -1, 0u);
}

extern "C" void kernel_launch(void* const* d_in, const int* in_sizes, int n_in, void* d_out, int out_size, void* d_ws, size_t ws_size, hipStream_t stream) {
    static int grid = 0;
    if (grid == 0) {
        if (n_in != 20 || (size_t)out_size != O_END || ws_size < WS_END) { fprintf(stderr, "kernel_launch: unexpected shapes: n_in %d out %d ws %zu (need %zu)\n", n_in, out_size, ws_size, (size_t)WS_END); grid = -1; return; }
        int dev = 0, cus = 0, per_cu = 0;
        hipGetDevice(&dev); hipDeviceGetAttribute(&cus, hipDeviceAttributeMultiprocessorCount, dev);
        if (hipFuncSetAttribute((const void*)yoco_fwd, hipFuncAttributeMaxDynamicSharedMemorySize, LDS_BYTES) != hipSuccess) { fprintf(stderr, "kernel_launch: hipFuncSetAttribute failed\n"); grid = -1; return; }
        if (hipOccupancyMaxActiveBlocksPerMultiprocessor(&per_cu, (const void*)yoco_fwd, NTHREADS, LDS_BYTES) != hipSuccess || per_cu < 1) { fprintf(stderr, "kernel_launch: occupancy query failed (%d)\n", per_cu); (void)hipGetLastError(); per_cu = 1; }
        grid = cus * per_cu;
    }
    if (grid < 0) return;
    Params p{};
    const float** pp = (const float**)&p;
    for (int i = 0; i < 20; ++i) pp[i] = (const float*)d_in[i];
    p.out = (float*)d_out; p.ws = (unsigned char*)d_ws; p.lo = 0; p.hi = NSTEPS;
    if (hipMemsetAsync((unsigned char*)d_ws + WS_CTL, 0, 32768, stream) != hipSuccess) { fprintf(stderr, "kernel_launch: memset failed\n"); return; }
    void* args[] = {&p};
    hipError_t e = hipLaunchCooperativeKernel((const void*)yoco_fwd, dim3(grid), dim3(NTHREADS), args, LDS_BYTES, stream);
    if (e != hipSuccess) fprintf(stderr, "kernel_launch: cooperative launch failed: %s (grid %d)\n", hipGetErrorString(e), grid);
}
```

```cpp
#include <hip/hip_runtime.h>
#include <hip/hip_cooperative_groups.h>
#include <cstdio>
#include <cstdint>
namespace cg = cooperative_groups;

constexpr int MP = 16384, MS = 256, MT = MP + MS, DM = 1024, FF = 2816, SEQ = 4096, NTM = MT / 256;
constexpr float EPS = 1e-6f;
constexpr float C2 = 0.125f * 1.4426950408889634f;
constexpr size_t O_YP = 0, O_YS = O_YP + (size_t)MP * DM, O_PP = O_YS + (size_t)MS * DM, O_PS = O_PP + 4 * 2 * 15 * 1024,
                 O_KP0 = O_PS + 32 * 2 * 15 * 1024, O_KS0 = O_KP0 + (size_t)4 * 128 * 2048, O_KP1 = O_KS0 + (size_t)32 * 128 * 2048,
                 O_KS1 = O_KP1 + (size_t)4 * 512 * 2048, O_KP2 = O_KS1 + (size_t)32 * 512 * 2048, O_KS2 = O_KP2 + (size_t)4 * 2048 * 2048,
                 O_END = O_KS2 + (size_t)32 * 2048 * 2048;
constexpr size_t AL(size_t x) { return (x + 65535) & ~(size_t)65535; }
constexpr size_t WS_WPOOL = 0;
constexpr size_t WS_WGU = AL(WS_WPOOL + (size_t)8 * 65536 * 2);
constexpr size_t WS_WDN = AL(WS_WGU + (size_t)4 * 5632 * 1024 * 2);
constexpr size_t WS_WKVQ = AL(WS_WDN + (size_t)4 * 1024 * 2816 * 2);
constexpr size_t WS_WQ1 = AL(WS_WKVQ + (size_t)9216 * 1024 * 2);
constexpr size_t WS_WO = AL(WS_WQ1 + (size_t)3072 * 1024 * 2);
constexpr size_t WS_DBUF = AL(WS_WO + (size_t)2 * 1024 * 1024 * 2);
constexpr size_t WS_XB = AL(WS_DBUF + (size_t)4 * MT * 256 * 2);
constexpr size_t WS_H = AL(WS_XB + (size_t)MT * 1024 * 2);
constexpr size_t WS_KB = AL(WS_H + (size_t)MT * FF * 2);
constexpr size_t WS_VB = AL(WS_KB + (size_t)3 * MP * 1024 * 2);
constexpr size_t WS_QB = AL(WS_VB + (size_t)3 * MP * 1024 * 2);
constexpr size_t WS_OG = AL(WS_QB + (size_t)3 * MP * 1024 * 2);
constexpr size_t WS_LSE = AL(WS_OG + (size_t)3 * MP * 1024 * 2);
constexpr size_t WS_OB = AL(WS_LSE + (size_t)3 * MP * 16 * 4);
constexpr size_t WS_QS = AL(WS_OB + (size_t)MT * 1024 * 2);
constexpr size_t WS_SSQ = AL(WS_QS + (size_t)256 * 3072 * 4);
constexpr size_t WS_ROPE = AL(WS_SSQ + (size_t)8 * MT * 4);
constexpr size_t WS_CTL = AL(WS_ROPE + (size_t)2 * 4104 * 32 * 4);
constexpr size_t CKV_ROWS = 136 + 520 + 1032;
constexpr size_t WS_CK = AL(WS_CTL + 32768);
constexpr size_t WS_CV = AL(WS_CK + (size_t)512 * CKV_ROWS * 64 * 2);
constexpr size_t WS_END = AL(WS_CV + (size_t)512 * CKV_ROWS * 64 * 2);

struct Params {
    const float *x_prompt, *x_sample, *state_pool, *cache0, *cache1, *cache2, *a_norm, *pool_w, *pool_scale, *kv_norm, *w_kv, *k_norm, *b_norm, *w_q, *q_norm, *w_o,
        *ffn_norm, *w_gate, *w_up, *w_down;
    float* out; unsigned char* ws; int lo, hi;
};

__device__ __forceinline__ int opaque_tid() { int t = threadIdx.x; asm volatile("" : "+v"(t)); return t; }
namespace pg8 {
#define PG8_LAS __attribute__((address_space(3)))
typedef unsigned short bf16_t;
typedef short bf16x8 __attribute__((ext_vector_type(8)));
typedef float f32x4 __attribute__((ext_vector_type(4)));
typedef unsigned u32x4 __attribute__((ext_vector_type(4)));
typedef unsigned u32x2 __attribute__((ext_vector_type(2)));
constexpr int BM = 256, BK = 64, HALF = 128, HTB = HALF * BK * 2  , STAGE_BYTES = 8 * HTB, NXCD = 8, WGM = 8;

__host__ __device__ __forceinline__ int lds_byte(int r, int c) { const int st = (r >> 4) * 2 + (c >> 5), rr = r & 15, cc = c & 31, ob = rr * 64 + cc * 2; return st * 1024 + (ob ^ (((ob >> 9) & 1) << 5)); }
__host__ __device__ __forceinline__ void stage_rc(int b, int& R, int& C) { const int st = b / 1024, sb = b % 1024, swz = sb ^ (((sb >> 9) & 1) << 5); R = (st >> 1) * 16 + swz / 64; C = (st & 1) * 32 + (swz % 64) / 2; }
__host__ __device__ __forceinline__ int perm32(int rho) { const int n = rho >> 4, i = rho & 15; return 8 * (i >> 2) + 4 * n + (i & 3); }

struct Unit { int pm, pn, rowt, colt; };
struct Gemm { const bf16_t* A; const bf16_t* Bt; int M, N, K; };

struct StaticOrder {
    int nM, nN, nwg, G, c, mode; unsigned* cnt;
    __device__ void init(int M, int N, int G_, int c_, int mode_) { nM = M / BM; nN = N / BM; nwg = nM * nN; G = G_; c = c_; mode = mode_; cnt = nullptr; }
    __device__ bool next(int i, Unit& u) const {
        if (mode == 4) { if (i > 0) return false; u.pm = nM; u.pn = c; u.rowt = nM; u.colt = c; return true; }
        const long L = (long)i * G + c;
        int wgid = (int)L, nw = nwg, nm = nM;
        if (mode == 3) {
            if (L >= nwg + nN) return false;
            if (L < nN) { u.pm = nM; u.pn = (int)L; u.rowt = nM; u.colt = (int)L; return true; }
            wgid -= nN;
        } else if (L >= nwg) return false;
        if (mode == 1) { const int g = wgid / NTM, m = wgid % NTM; u.pm = g * NTM + m; u.pn = g; u.rowt = m; u.colt = g; return true; }
        { const int q = nw / NXCD, r = nw % NXCD, xcd = wgid % NXCD, off = wgid / NXCD; wgid = (xcd < r ? xcd * (q + 1) : r * (q + 1) + (xcd - r) * q) + off; }
        const int nig = WGM * nN, gid = wgid / nig, fm = gid * WGM, gsz = (nm - fm) < WGM ? (nm - fm) : WGM;
        u.pm = fm + ((wgid % nig) % gsz); u.pn = (wgid % nig) / gsz; u.rowt = u.pm; u.colt = u.pn; return true;
    }
    __device__ __forceinline__ void a_ready(const Unit&) const {}
    __device__ __forceinline__ void done(const Unit& u) const {
        if (mode == 3 && u.rowt == nM) {
            asm volatile("s_waitcnt vmcnt(0)" ::: "memory");
            __builtin_amdgcn_s_barrier();
            if (threadIdx.x == 0) atomicAdd(cnt, 1u);
        }
    }
};

__device__ __forceinline__ unsigned cvt_pk_bf16(float lo, float hi) { unsigned r; asm volatile("v_cvt_pk_bf16_f32 %0, %1, %2" : "=v"(r) : "v"(lo), "v"(hi)); return r; }


struct EpiResid {
    static constexpr bool PERM = false, AFTER_DRAIN = false;
    const float* xin_p; const float* xin_s; float* X; const float* scale; bf16_t* xb; float* ssq;
    __device__ __forceinline__ void operator()(const f32x4 (&acc)[2][2][4][2], const Unit& u, int wr, int wc, int fr, int fq) const {
        const int colbase = u.colt * BM + wc * 32 + fq * 4;
        f32x4 sc[2][2];
#pragma unroll
        for (int bj = 0; bj < 2; ++bj)
#pragma unroll
            for (int n = 0; n < 2; ++n) sc[bj][n] = scale ? *(const f32x4*)(scale + colbase + bj * HALF + n * 16) : (f32x4){1.f, 1.f, 1.f, 1.f};
#pragma unroll
        for (int ai = 0; ai < 2; ++ai) {
            const int row0 = u.rowt * BM + ai * HALF + wr * 64 + fr;
            const float* xi0 = (row0 < MP) ? xin_p + (size_t)row0 * DM : xin_s + (size_t)(row0 - MP) * DM;
            f32x4 xv[4][2][2];
#pragma unroll
            for (int m = 0; m < 4; ++m)
#pragma unroll
                for (int bj = 0; bj < 2; ++bj)
#pragma unroll
                    for (int n = 0; n < 2; ++n) xv[m][bj][n] = *(const f32x4*)(xi0 + (size_t)m * 16 * DM + colbase + bj * HALF + n * 16);
            asm volatile("" ::: "memory");
#pragma unroll
            for (int m = 0; m < 4; ++m) {
                const int row = row0 + m * 16;
                float* xo = X + (size_t)row * DM; float ss = 0.f;
#pragma unroll
                for (int bj = 0; bj < 2; ++bj)
#pragma unroll
                    for (int n = 0; n < 2; ++n) {
                        const int col = colbase + bj * HALF + n * 16;
                        const f32x4 v = xv[m][bj][n] + acc[ai][bj][m][n] * sc[bj][n];
                        *(f32x4*)(xo + col) = v;
                        if (xb) { u32x2 w; w.x = cvt_pk_bf16(v[0], v[1]); w.y = cvt_pk_bf16(v[2], v[3]); *(u32x2*)(xb + (size_t)row * DM + col) = w; }
                        ss += (v[0] * v[0] + v[1] * v[1]) + (v[2] * v[2] + v[3] * v[3]);
                    }
                if (ssq) { ss += __shfl_xor(ss, 16); ss += __shfl_xor(ss, 32); if (fq == 0) atomicAdd(ssq + row, ss); }
            }
            asm volatile("" ::: "memory");
        }
    }
};

struct EpiGU {
    static constexpr bool PERM = false, AFTER_DRAIN = false;
    const float* ssq; bf16_t* H;
    __device__ __forceinline__ void operator()(const f32x4 (&acc)[2][2][4][2], const Unit& u, int wr, int wc, int fr, int fq) const {
        float rsv[2][4];
#pragma unroll
        for (int ai = 0; ai < 2; ++ai)
#pragma unroll
            for (int m = 0; m < 4; ++m) rsv[ai][m] = ssq[u.rowt * BM + ai * HALF + wr * 64 + m * 16 + fr];
#pragma unroll
        for (int ai = 0; ai < 2; ++ai)
#pragma unroll
            for (int m = 0; m < 4; ++m) {
                const int row = u.rowt * BM + ai * HALF + wr * 64 + m * 16 + fr;
                const float rs = __builtin_amdgcn_rsqf(rsv[ai][m] * (1.0f / DM) + EPS);
#pragma unroll
                for (int bj = 0; bj < 2; ++bj) {
                    const int hcol = u.colt * 128 + bj * 64 + wc * 16 + fq * 4;
                    const f32x4 g = acc[ai][bj][m][0] * rs, up = acc[ai][bj][m][1] * rs; float o[4];
#pragma unroll
                    for (int e = 0; e < 4; ++e) { const float sg = __builtin_amdgcn_rcpf(1.0f + __builtin_amdgcn_exp2f(-1.4426950408889634f * g[e])); o[e] = g[e] * sg * up[e]; }
                    u32x2 w; w.x = cvt_pk_bf16(o[0], o[1]); w.y = cvt_pk_bf16(o[2], o[3]);
                    if (u.rowt == MP / BM) __hip_atomic_store((unsigned long long*)(H + (size_t)row * FF + hcol), ((unsigned long long)w.y << 32) | (unsigned long long)w.x, __ATOMIC_RELAXED, __HIP_MEMORY_SCOPE_AGENT);
                    else *(u32x2*)(H + (size_t)row * FF + hcol) = w;
                }
            }
    }
};

__device__ __forceinline__ size_t hm_off(int g, int row, int h) {
    const int pos = row & (SEQ - 1), b = row >> 12, sh = 2 * g;
    const int sig = ((pos & ((1 << sh) - 1)) << (12 - sh)) + (pos >> sh);
    return ((size_t)((g * 4 + b) * 16 + h) * SEQ + sig) * 64;
}
__device__ __forceinline__ size_t ckv_off(int g, int n, int h, int idxc) {
    const size_t gbase = g == 0 ? 0 : (g == 1 ? (size_t)512 * 136 : (size_t)512 * (136 + 520));
    const int rc = g == 0 ? 136 : (g == 1 ? 520 : 1032);
    return (gbase + (size_t)(n * 16 + h) * rc + idxc) * 64;
}
struct EpiQKV {
    static constexpr bool PERM = false, AFTER_DRAIN = false;
    const float* ssq; int tile_base; const float* k_norm; const float* q_norm; const float* ropec; const float* ropes;
    bf16_t* Kb; bf16_t* Vb; bf16_t* Qb; float* QS; float* out; bf16_t* CK; bf16_t* CV;
    __device__ __forceinline__ void operator()(const f32x4 (&acc)[2][2][4][2], const Unit& u, int wr, int wc, int fr, int fq) const {
        const int tile = u.colt + tile_base, type = tile / 12, G = 4 * (tile % 12) + wc, g = G >> 4, h = G & 15;
        const int hist = 128 << (2 * g);
        const float* gn = (type == 0 ? k_norm : q_norm) + g * 64;
        const size_t okp = g == 0 ? O_KP0 : (g == 1 ? O_KP1 : O_KP2), oks = g == 0 ? O_KS0 : (g == 1 ? O_KS1 : O_KS2);
        f32x4 gA[2], gB[2];
#pragma unroll
        for (int n = 0; n < 2; ++n) { gA[n] = *(const f32x4*)(gn + n * 16 + fq * 4); gB[n] = *(const f32x4*)(gn + 32 + n * 16 + fq * 4); }
#pragma unroll
        for (int ai = 0; ai < 2; ++ai)
#pragma unroll
            for (int mh = 0; mh < 2; ++mh) {
                float sq[2]; f32x4 cs[2][2], sn[2][2];
#pragma unroll
                for (int mm = 0; mm < 2; ++mm) {
                    const int row = u.rowt * BM + ai * HALF + wr * 64 + (2 * mh + mm) * 16 + fr;
                    sq[mm] = ssq[row];
                    if (type != 1) {
                        const int pi = row < MP ? (row & (SEQ - 1)) : SEQ + ((row - MP) & 7);
#pragma unroll
                        for (int n = 0; n < 2; ++n) { cs[mm][n] = *(const f32x4*)(ropec + pi * 32 + n * 16 + fq * 4); sn[mm][n] = *(const f32x4*)(ropes + pi * 32 + n * 16 + fq * 4); }
                    }
                }
                asm volatile("" ::: "memory");
#pragma unroll
                for (int mm = 0; mm < 2; ++mm) {
                    const int m = 2 * mh + mm;
                    const int row = u.rowt * BM + ai * HALF + wr * 64 + m * 16 + fr;
                    const float rs = __builtin_amdgcn_rsqf(sq[mm] * (1.0f / DM) + EPS);
                    f32x4 v[2][2];
#pragma unroll
                    for (int bj = 0; bj < 2; ++bj)
#pragma unroll
                        for (int n = 0; n < 2; ++n) v[bj][n] = acc[ai][bj][m][n] * rs;
                    if (type != 1) {
                        float ss = 0.f;
#pragma unroll
                        for (int bj = 0; bj < 2; ++bj)
#pragma unroll
                            for (int n = 0; n < 2; ++n) ss += (v[bj][n][0] * v[bj][n][0] + v[bj][n][1] * v[bj][n][1]) + (v[bj][n][2] * v[bj][n][2] + v[bj][n][3] * v[bj][n][3]);
                        ss += __shfl_xor(ss, 16); ss += __shfl_xor(ss, 32);
                        float hr = __builtin_amdgcn_rsqf(ss * (1.0f / 64.0f) + EPS);
                        if (type == 2) hr *= C2;
#pragma unroll
                        for (int n = 0; n < 2; ++n) {
                            const f32x4 a = v[0][n] * hr * gA[n], b = v[1][n] * hr * gB[n];
                            v[0][n] = a * cs[mm][n] - b * sn[mm][n]; v[1][n] = b * cs[mm][n] + a * sn[mm][n];
                        }
                    }
#pragma unroll
                    for (int bj = 0; bj < 2; ++bj)
#pragma unroll
                        for (int n = 0; n < 2; ++n) {
                            const int d = bj * 32 + n * 16 + fq * 4; const f32x4 x = v[bj][n];
                            u32x2 w; w.x = cvt_pk_bf16(x[0], x[1]); w.y = cvt_pk_bf16(x[2], x[3]);
                            if (type == 2) {
                                if (row < MP) *(u32x2*)(Qb + hm_off(g, row, h) + d) = w;
                                else *(f32x4*)(QS + (size_t)(row - MP) * 3072 + G * 64 + d) = x;
                            } else {
                                if (row < MP) {
                                    *(u32x2*)((type == 0 ? Kb : Vb) + hm_off(g, row, h) + d) = w;
                                    const int s = row & (SEQ - 1), b = row >> 12;
                                    if (s >= SEQ - hist) *(f32x4*)(out + okp + ((size_t)(b * hist + s - (SEQ - hist)) * 2 + type) * DM + h * 64 + d) = x;
                                } else {
                                    const int q = row - MP, n_ = q >> 3, t = q & 7;
                                    *(f32x4*)(out + oks + ((size_t)(n_ * hist + hist - 8 + t) * 2 + type) * DM + h * 64 + d) = x;
                                    *(u32x2*)((type == 0 ? CK : CV) + ckv_off(g, n_, h, (g == 2 ? 1024 : hist) + t) + d) = w;
                                }
                            }
                        }
                }
                asm volatile("" ::: "memory");
            }
    }
};

template <class Epi, class Sched, bool ALIGN_EPI = false, bool SP2 = false>
__device__ __forceinline__ void gemm_phase(PG8_LAS unsigned char* lds, const Gemm g, const Sched& S, const Epi& E) {
    const int tid = opaque_tid(), wid = __builtin_amdgcn_readfirstlane(tid >> 6), lane = tid & 63, wr = wid >> 2, wc = wid & 3, fr = lane & 15, fq = lane >> 4;
    const int K = g.K, nt = K / BK;
    unsigned voffA[2], voffB[2];
#pragma unroll
    for (int i = 0; i < 2; ++i) { int R, C; stage_rc(tid * 16 + i * 8192, R, C); const int Rb = Epi::PERM ? ((R & ~31) + perm32(R & 31)) : R;
        voffA[i] = (unsigned)(R * K + C) * 2u; voffB[i] = (unsigned)(Rb * K + C) * 2u; }
    const size_t kstep = (size_t)(BK * 2);
    const size_t hstep = (size_t)HALF * K * 2;
    const size_t tstep = 2 * hstep;
    const unsigned ldsw = (unsigned)wid * 1024u;
    const int aoff = lds_byte(wr * 64 + fr, fq * 8), boff = lds_byte(wc * 32 + fr, fq * 8);
#define PG8_SA(b, h) (((b) * 2 + (h)) * HTB)
#define PG8_SB(b, h) ((4 + (b) * 2 + (h)) * HTB)
#define PG8_STAGE(bufoff, gbase, voff) do { _Pragma("unroll") for (int _i = 0; _i < 2; ++_i) \
        __builtin_amdgcn_global_load_lds((const unsigned*)((const char*)(gbase) + (voff)[_i]), (PG8_LAS unsigned*)(lds + (bufoff) + ldsw + _i * 8192), 16, 0, 0); } while (0)
#define PG8_LDA(dst, b, h) do { _Pragma("unroll") for (int m = 0; m < 4; ++m) _Pragma("unroll") for (int k = 0; k < 2; ++k) dst[m][k] = *(const PG8_LAS bf16x8*)(lds + PG8_SA(b, h) + aoff + m * 2048 + k * 1024); } while (0)
#define PG8_LDB(dst, b, h) do { _Pragma("unroll") for (int n = 0; n < 2; ++n) _Pragma("unroll") for (int k = 0; k < 2; ++k) dst[n][k] = *(const PG8_LAS bf16x8*)(lds + PG8_SB(b, h) + boff + n * 2048 + k * 1024); } while (0)
#define PG8_MMA(ai, bj, At, Bt) do { __builtin_amdgcn_s_setprio(1); _Pragma("unroll") for (int m = 0; m < 4; ++m) _Pragma("unroll") for (int n = 0; n < 2; ++n) _Pragma("unroll") for (int k = 0; k < 2; ++k) \
        acc[ai][bj][m][n] = __builtin_amdgcn_mfma_f32_16x16x32_bf16(Bt[n][k], At[m][k], acc[ai][bj][m][n], 0, 0, 0); __builtin_amdgcn_s_setprio(0); } while (0)
#define PG8_WAIT_V(n) asm volatile("s_waitcnt vmcnt(" #n ")" ::: "memory")
#define PG8_WAIT_L(n) asm volatile("s_waitcnt lgkmcnt(" #n ")" ::: "memory")
#define PG8_BAR __builtin_amdgcn_s_barrier()
#define PG8_SCHED __builtin_amdgcn_sched_barrier(0)
    Unit cur, nxt; int ui = 0;
    if (!S.next(0, cur)) return;
    f32x4 acc[2][2][4][2];
#pragma unroll
    for (int a = 0; a < 2; ++a)
#pragma unroll
        for (int b = 0; b < 2; ++b)
#pragma unroll
            for (int m = 0; m < 4; ++m)
#pragma unroll
                for (int n = 0; n < 2; ++n) acc[a][b][m][n] = (f32x4){0.f, 0.f, 0.f, 0.f};
    bf16x8 At[4][2], B0[2][2], B1[2][2];
    const char* cA = (const char*)g.A + (size_t)cur.pm * tstep; const char* cB = (const char*)g.Bt + (size_t)cur.pn * tstep;
    S.a_ready(cur);
    if constexpr (SP2) {
        PG8_STAGE(PG8_SB(0, 0), cB, voffB); PG8_STAGE(PG8_SB(0, 1), cB + hstep, voffB); PG8_STAGE(PG8_SA(0, 0), cA, voffA); PG8_STAGE(PG8_SA(0, 1), cA + hstep, voffA);
        if (wr == 1) PG8_BAR;
        PG8_WAIT_V(2); PG8_BAR;
        PG8_STAGE(PG8_SB(1, 0), cB + kstep, voffB); PG8_STAGE(PG8_SA(1, 0), cA + kstep, voffA); PG8_STAGE(PG8_SB(1, 1), cB + hstep + kstep, voffB);
        PG8_WAIT_V(6); PG8_BAR;
    } else {
        PG8_STAGE(PG8_SB(0, 0), cB, voffB); PG8_STAGE(PG8_SA(0, 0), cA, voffA); PG8_STAGE(PG8_SB(0, 1), cB + hstep, voffB); PG8_STAGE(PG8_SA(0, 1), cA + hstep, voffA);
        if (wr == 1) PG8_BAR;
        PG8_WAIT_V(4); PG8_BAR;
        PG8_STAGE(PG8_SB(1, 0), cB + kstep, voffB); PG8_STAGE(PG8_SA(1, 0), cA + kstep, voffA); PG8_STAGE(PG8_SB(1, 1), cB + hstep + kstep, voffB);
        PG8_WAIT_V(6); PG8_BAR;
    }
    for (;;) {
        const bool has_next = S.next(ui + 1, nxt);
        const char* nA = has_next ? (const char*)g.A + (size_t)nxt.pm * tstep : cA; const char* nB = has_next ? (const char*)g.Bt + (size_t)nxt.pn * tstep : cB;
        for (int t = 0; t < nt; t += 2) {
            const bool last = (t == nt - 2);
            const char* a1 = cA + (size_t)(t + 1) * kstep;
            const char* a2 = last ? nA : cA + (size_t)(t + 2) * kstep; const char* b2 = last ? nB : cB + (size_t)(t + 2) * kstep;
            const char* a3 = a2 + kstep; const char* b3 = b2 + kstep;
            if (last && has_next) S.a_ready(nxt);
            if constexpr (SP2) {
            PG8_LDB(B0, 0, 0); PG8_LDB(B1, 0, 1); PG8_SCHED; PG8_LDA(At, 0, 0); PG8_STAGE(PG8_SA(1, 1), a1 + hstep, voffA);
            PG8_WAIT_V(8); PG8_WAIT_L(0); PG8_BAR; PG8_MMA(0, 0, At, B0); PG8_MMA(0, 1, At, B1); PG8_BAR; PG8_SCHED;
            PG8_LDA(At, 0, 1); PG8_STAGE(PG8_SB(0, 0), b2, voffB); PG8_STAGE(PG8_SB(0, 1), b2 + hstep, voffB); PG8_STAGE(PG8_SA(0, 0), a2, voffA);
            PG8_WAIT_V(8); PG8_WAIT_L(0); PG8_BAR; PG8_MMA(1, 0, At, B0); PG8_MMA(1, 1, At, B1); PG8_BAR; PG8_SCHED;
            PG8_LDB(B0, 1, 0); PG8_LDB(B1, 1, 1); PG8_SCHED; PG8_LDA(At, 1, 0); PG8_STAGE(PG8_SA(0, 1), a2 + hstep, voffA);
            PG8_WAIT_V(8); PG8_WAIT_L(0); PG8_BAR; PG8_MMA(0, 0, At, B0); PG8_MMA(0, 1, At, B1); PG8_BAR; PG8_SCHED;
            PG8_LDA(At, 1, 1); PG8_STAGE(PG8_SB(1, 0), b3, voffB); PG8_STAGE(PG8_SB(1, 1), b3 + hstep, voffB); PG8_STAGE(PG8_SA(1, 0), a3, voffA);
            PG8_WAIT_V(8); PG8_WAIT_L(0); PG8_BAR; PG8_MMA(1, 0, At, B0); PG8_MMA(1, 1, At, B1); PG8_BAR; PG8_SCHED;
            } else {
            PG8_LDB(B0, 0, 0); PG8_SCHED; PG8_LDA(At, 0, 0); PG8_STAGE(PG8_SA(1, 1), a1 + hstep, voffA);
            PG8_WAIT_L(8); PG8_BAR; PG8_WAIT_L(0); PG8_MMA(0, 0, At, B0); PG8_BAR; PG8_SCHED;
            PG8_LDB(B1, 0, 1); PG8_STAGE(PG8_SB(0, 0), b2, voffB);
            PG8_BAR; PG8_WAIT_L(0); PG8_MMA(0, 1, At, B1); PG8_BAR;
            PG8_LDA(At, 0, 1); PG8_STAGE(PG8_SA(0, 0), a2, voffA);
            PG8_BAR; PG8_WAIT_L(0); PG8_MMA(1, 0, At, B0); PG8_BAR; PG8_SCHED;
            PG8_STAGE(PG8_SB(0, 1), b2 + hstep, voffB);
            PG8_WAIT_V(6); PG8_BAR; PG8_MMA(1, 1, At, B1); PG8_BAR;
            PG8_LDB(B0, 1, 0); PG8_SCHED; PG8_LDA(At, 1, 0); PG8_STAGE(PG8_SA(0, 1), a2 + hstep, voffA);
            PG8_WAIT_L(8); PG8_BAR; PG8_WAIT_L(0); PG8_MMA(0, 0, At, B0); PG8_BAR; PG8_SCHED;
            PG8_LDB(B1, 1, 1); PG8_STAGE(PG8_SB(1, 0), b3, voffB);
            PG8_BAR; PG8_WAIT_L(0); PG8_MMA(0, 1, At, B1); PG8_BAR;
            PG8_LDA(At, 1, 1); PG8_STAGE(PG8_SA(1, 0), a3, voffA);
            PG8_BAR; PG8_WAIT_L(0); PG8_MMA(1, 0, At, B0); PG8_BAR; PG8_SCHED;
            PG8_STAGE(PG8_SB(1, 1), b3 + hstep, voffB);
            PG8_WAIT_V(6); PG8_BAR; PG8_MMA(1, 1, At, B1); PG8_BAR;
            }
        }
        if constexpr (ALIGN_EPI) { if (wr == 0) PG8_BAR; }
        if constexpr (!Epi::AFTER_DRAIN) { E(acc, cur, wr, wc, fr, fq); S.done(cur); }
        if (!has_next) break;
#pragma unroll
        for (int a = 0; a < 2; ++a)
#pragma unroll
            for (int b = 0; b < 2; ++b)
#pragma unroll
                for (int m = 0; m < 4; ++m)
#pragma unroll
                    for (int n = 0; n < 2; ++n) acc[a][b][m][n] = (f32x4){0.f, 0.f, 0.f, 0.f};
        cur = nxt; cA = nA; cB = nB; ++ui;
        if constexpr (ALIGN_EPI) { if (wr == 1) PG8_BAR; }
    }
    PG8_WAIT_V(0);
    if constexpr (!ALIGN_EPI) { if (wr == 0) PG8_BAR; }
    PG8_BAR;
    if constexpr (Epi::AFTER_DRAIN) { E.fused(acc, cur, wr, wc, fr, fq, lds, wid, lane); S.done(cur); }
#undef PG8_SA
#undef PG8_SB
#undef PG8_STAGE
#undef PG8_LDA
#undef PG8_LDB
#undef PG8_MMA
#undef PG8_WAIT_V
#undef PG8_WAIT_L
#undef PG8_BAR
#undef PG8_SCHED
}
}

#define LAS __attribute__((address_space(3)))
typedef unsigned short bf16_t;
typedef short bf16x8 __attribute__((ext_vector_type(8)));
typedef short s16x4 __attribute__((ext_vector_type(4)));
typedef float f32x4 __attribute__((ext_vector_type(4)));
typedef float f32x16 __attribute__((ext_vector_type(16)));
typedef unsigned u32x4 __attribute__((ext_vector_type(4)));
typedef unsigned u32x2 __attribute__((ext_vector_type(2)));
constexpr int NWAVES = 8, NTHREADS = 512;
constexpr int LDS_BYTES = 147456;

__device__ __forceinline__ unsigned pk_bf16(float lo, float hi) { return pg8::cvt_pk_bf16(lo, hi); }

__constant__ double INV_FREQ[32] = {1.0, 0.7498942093324559, 0.5623413251903491, 0.4216965034285822, 0.31622776601683794, 0.23713737056616552, 0.1778279410038923, 0.1333521432163324, 0.1,
    0.07498942093324558, 0.05623413251903491, 0.042169650342858224, 0.03162277660168379, 0.023713737056616554, 0.01778279410038923, 0.01333521432163324, 0.01, 0.007498942093324558,
    0.005623413251903491, 0.004216965034285823, 0.0031622776601683794, 0.0023713737056616554, 0.0017782794100389228, 0.001333521432163324, 0.001, 0.0007498942093324559,
    0.0005623413251903491, 0.00042169650342858224, 0.00031622776601683794, 0.00023713737056616554, 0.00017782794100389227, 0.0001333521432163324};

__device__ __forceinline__ void wconv_item(const float* src, const float* src2, int K, int Nsrc, bf16_t* dst, int Ndst, int mode, const float* gain, LAS float* scr, int item, int lane) {
    const int nblk = Ndst / 32, kb = item / nblk, nb = item % nblk, k0 = 64 * kb, n0 = 32 * nb;
    const int np = n0 + (lane & 31);
    const float* s = src; int col = np;
    if (mode == 1) { col = (np >> 5) * 16 + (np & 15); if ((np >> 4) & 1) s = src2; }
    else if (mode == 2) { const int pn = np >> 8, bj = (np >> 7) & 1, wc = (np >> 5) & 3, j = np & 31; col = (4 * pn + wc) * 64 + 32 * bj + j; }
    float wv[32];
#pragma unroll
    for (int i = 0; i < 32; ++i) { const int kk = 2 * i + (lane >> 5); wv[i] = s[(size_t)(k0 + kk) * Nsrc + col]; }
    if (gain) {
#pragma unroll
        for (int i = 0; i < 32; ++i) { const int kk = 2 * i + (lane >> 5); wv[i] *= gain[k0 + kk]; }
    }
#pragma unroll
    for (int i = 0; i < 32; ++i) { const int kk = 2 * i + (lane >> 5); scr[kk * 33 + (lane & 31)] = wv[i]; }
    asm volatile("s_waitcnt lgkmcnt(0)" ::: "memory");
    const int c = lane & 7;
#pragma unroll
    for (int j = 0; j < 4; ++j) { const int n = (lane >> 3) + 8 * j; const LAS float* t = scr + (8 * c) * 33 + n;
        u32x4 o; o.x = pk_bf16(t[0 * 33], t[1 * 33]); o.y = pk_bf16(t[2 * 33], t[3 * 33]); o.z = pk_bf16(t[4 * 33], t[5 * 33]); o.w = pk_bf16(t[6 * 33], t[7 * 33]);
        *(u32x4*)(dst + (size_t)(n0 + n) * K + k0 + 8 * c) = o; }
    asm volatile("s_waitcnt lgkmcnt(0)" ::: "memory");
}

__device__ __forceinline__ void prep_weights(const Params& p, LAS unsigned char* lds, int gw, int NGW, int wave, int lane) {
    LAS float* scr = (LAS float*)(lds + wave * 8704);
    unsigned char* ws = p.ws;
    for (int id = 0; id < 21; ++id) {
        const float* src; const float* src2 = nullptr; int K, Nsrc, Ndst, mode = 0; bf16_t* dst; const float* gain = nullptr;
        if (id < 8) { src = p.pool_w + (size_t)id * 65536; K = 256; Nsrc = 256; Ndst = 256; dst = (bf16_t*)(ws + WS_WPOOL) + (size_t)id * 65536; }
        else if (id < 12) { const int l = id - 8; src = p.w_gate + (size_t)l * DM * FF; src2 = p.w_up + (size_t)l * DM * FF; K = DM; Nsrc = FF; Ndst = 2 * FF; mode = 1;
                            dst = (bf16_t*)(ws + WS_WGU) + (size_t)l * 2 * FF * DM; gain = p.ffn_norm + l * DM; }
        else if (id < 16) { const int l = id - 12; src = p.w_down + (size_t)l * FF * DM; K = FF; Nsrc = DM; Ndst = DM; dst = (bf16_t*)(ws + WS_WDN) + (size_t)l * DM * FF; }
        else if (id == 16) { src = p.w_kv; K = DM; Nsrc = 6144; Ndst = 6144; mode = 2; dst = (bf16_t*)(ws + WS_WKVQ); gain = p.kv_norm; }
        else if (id == 17) { src = p.w_q; K = DM; Nsrc = 3072; Ndst = 3072; mode = 2; dst = (bf16_t*)(ws + WS_WKVQ) + (size_t)6144 * DM; gain = p.b_norm; }
        else if (id == 18) { src = p.w_q + (size_t)DM * 3072; K = DM; Nsrc = 3072; Ndst = 3072; mode = 2; dst = (bf16_t*)(ws + WS_WQ1); gain = p.b_norm + DM; }
        else { const int j = id - 19; src = p.w_o + (size_t)j * DM * DM; K = DM; Nsrc = DM; Ndst = DM; dst = (bf16_t*)(ws + WS_WO) + (size_t)j * DM * DM; }
        const int nitems = (K / 64) * (Ndst / 32);
        for (int it = gw; it < nitems; it += NGW) wconv_item(src, src2, K, Nsrc, dst, Ndst, mode, gain, scr, it, lane);
    }
}

template <int W> __device__ __forceinline__ void pool_rows_prompt(const Params& p, int layer, const float* xp, const LAS float* rst, int t0, int half, int c4, int g, f32x4 gn, bf16_t* Dbuf) {
    const int rfirst = t0 + half * 16, r0 = rfirst - (W - 1), bstart = t0 & ~(SEQ - 1);
    f32x4 u[W + 15];
    const float* xr = xp + (size_t)r0 * DM + c4;
#pragma unroll
    for (int k = 0; k < W + 15; ++k) { const int r = r0 + k; u[k] = (f32x4){0.f, 0.f, 0.f, 0.f}; if (r >= bstart) u[k] = *(const f32x4*)xr; xr += DM; asm volatile("" : "+v"(xr)); }
#pragma unroll
    for (int k = 0; k < W + 15; ++k) { const int r = r0 + k; if (r >= bstart) u[k] = u[k] * rst[r - (t0 - 15)] * gn; }
    f32x4 S = {0.f, 0.f, 0.f, 0.f};
#pragma unroll
    for (int k = 0; k < W - 1; ++k) S += u[k];
#pragma unroll
    for (int i = 0; i < 16; ++i) {
        const int r = rfirst + i; const f32x4 uu = u[W - 1 + i];
        S += uu;
        const int s1 = (r & (SEQ - 1)) + 1; const int cnt = s1 < W ? s1 : W;
        const f32x4 d = S * (1.0f / (float)cnt) - uu;
        u32x2 wv; wv.x = pk_bf16(d[0], d[1]); wv.y = pk_bf16(d[2], d[3]);
        *(u32x2*)(Dbuf + ((size_t)g * MT + r) * 256 + (c4 - 256 * g)) = wv;
        const int s = r & (SEQ - 1), b = r >> 12;
        if (s >= SEQ - 15) *(f32x4*)(p.out + O_PP + ((size_t)(b * 2 + layer) * 15 + (s - (SEQ - 15))) * DM + c4) = uu;
        S -= u[i];
    }
}
template <int W> __device__ __forceinline__ void pool_rows_sample(const Params& p, int layer, const float* xs, const LAS float* rst, int n, int half, int c4, int g, f32x4 gn, bf16_t* Dbuf) {
    const int e0 = 15 + 4 * half - (W - 1);
    const float* sp = p.state_pool + (size_t)(n * 2 + layer) * 15 * DM + c4;
    f32x4 u[W + 3];
#pragma unroll
    for (int k = 0; k < W + 3; ++k) { const int e = e0 + k; u[k] = (e < 15) ? *(const f32x4*)(sp + (size_t)e * DM) : *(const f32x4*)(xs + (size_t)(n * 8 + e - 15) * DM + c4) * rst[e - 15] * gn; }
    f32x4 S = {0.f, 0.f, 0.f, 0.f};
#pragma unroll
    for (int k = 0; k < W - 1; ++k) S += u[k];
    float* po = p.out + O_PS + (size_t)(n * 2 + layer) * 15 * DM + c4;
#pragma unroll
    for (int i = 0; i < 4; ++i) {
        const int t = 4 * half + i, r = MP + n * 8 + t; const f32x4 uu = u[W - 1 + i];
        S += uu;
        const f32x4 d = S * (1.0f / (float)W) - uu;
        u32x2 wv; wv.x = pk_bf16(d[0], d[1]); wv.y = pk_bf16(d[2], d[3]);
        *(u32x2*)(Dbuf + ((size_t)g * MT + r) * 256 + (c4 - 256 * g)) = wv;
        *(f32x4*)(po + (size_t)(7 + t) * DM) = uu;
        S -= u[i];
    }
    if (half == 0) {
#pragma unroll
        for (int k = 0; k < 7; ++k) *(f32x4*)(po + (size_t)k * DM) = *(const f32x4*)(sp + (size_t)(8 + k) * DM);
    }
}
__device__ __forceinline__ float row_ssq3(const float* r0, const float* r1, const float* r2, int lane, float& s1, float& s2) {
    f32x4 v[12];
#pragma unroll
    for (int j = 0; j < 4; ++j) { v[j] = *(const f32x4*)(r0 + 4 * lane + 256 * j); v[4 + j] = *(const f32x4*)(r1 + 4 * lane + 256 * j); v[8 + j] = *(const f32x4*)(r2 + 4 * lane + 256 * j); }
    float a = 0.f, b = 0.f, c = 0.f;
#pragma unroll
    for (int j = 0; j < 4; ++j) { a += (v[j][0] * v[j][0] + v[j][1] * v[j][1]) + (v[j][2] * v[j][2] + v[j][3] * v[j][3]);
        b += (v[4 + j][0] * v[4 + j][0] + v[4 + j][1] * v[4 + j][1]) + (v[4 + j][2] * v[4 + j][2] + v[4 + j][3] * v[4 + j][3]);
        c += (v[8 + j][0] * v[8 + j][0] + v[8 + j][1] * v[8 + j][1]) + (v[8 + j][2] * v[8 + j][2] + v[8 + j][3] * v[8 + j][3]); }
#pragma unroll
    for (int o = 1; o < 64; o <<= 1) { a += __shfl_xor(a, o); b += __shfl_xor(b, o); c += __shfl_xor(c, o); }
    s1 = b; s2 = c; return a;
}
__device__ __forceinline__ void pool_prep(const Params& p, int layer, LAS unsigned char* lds) {
    const int tid = opaque_tid(), lane = tid & 63, wave = tid >> 6;
    LAS float* rst = (LAS float*)(lds + 73728);
    const float* xp = layer == 0 ? p.x_prompt : p.out + O_YP;
    const float* xs = layer == 0 ? p.x_sample : p.out + O_YS;
    const float* gain = p.a_norm + layer * DM;
    bf16_t* Dbuf = (bf16_t*)(p.ws + WS_DBUF);
    const int c4 = (tid & 255) * 4, half = tid >> 8, g = (tid & 255) >> 6;
    const f32x4 gn = *(const f32x4*)(gain + c4);
    const int vblk = (gridDim.x & 7) == 0 ? (int)((blockIdx.x & 7) * (gridDim.x >> 3) + (blockIdx.x >> 3)) : (int)blockIdx.x;
    for (int it = vblk; it < MP / 32; it += gridDim.x) {
        {
            const int t0 = it * 32;
            const bool halo = (t0 & (SEQ - 1)) != 0;
#pragma unroll
            for (int bt = 0; bt < 2; ++bt) {
                int rr[3]; const float* rp[3];
#pragma unroll
                for (int q = 0; q < 3; ++q) { rr[q] = wave + 8 * (3 * bt + q); int r = t0 - 15 + rr[q]; const bool ok = rr[q] < 47 && (rr[q] >= 15 || halo); if (!ok) r = t0; rp[q] = xp + (size_t)r * DM; }
                float s1, s2; const float s0 = row_ssq3(rp[0], rp[1], rp[2], lane, s1, s2);
                if (lane == 0) { if (rr[0] < 47) rst[rr[0]] = 1.0f / sqrtf(s0 * (1.0f / DM) + EPS); if (rr[1] < 47) rst[rr[1]] = 1.0f / sqrtf(s1 * (1.0f / DM) + EPS); if (rr[2] < 47) rst[rr[2]] = 1.0f / sqrtf(s2 * (1.0f / DM) + EPS); }
            }
            __syncthreads();
            if (g == 0) pool_rows_prompt<2>(p, layer, xp, rst, t0, half, c4, g, gn, Dbuf);
            else if (g == 1) pool_rows_prompt<4>(p, layer, xp, rst, t0, half, c4, g, gn, Dbuf);
            else if (g == 2) pool_rows_prompt<8>(p, layer, xp, rst, t0, half, c4, g, gn, Dbuf);
            else pool_rows_prompt<16>(p, layer, xp, rst, t0, half, c4, g, gn, Dbuf);
        }
        __syncthreads();
    }
    for (int it = gridDim.x - 1 - blockIdx.x; it < 32; it += gridDim.x) {
        {
            const int n = it;
            { const float* row = xs + (size_t)(n * 8 + wave) * DM; float ss = 0.f;
#pragma unroll
              for (int j = 0; j < 4; ++j) { const f32x4 v = *(const f32x4*)(row + 4 * lane + 256 * j); ss += (v[0] * v[0] + v[1] * v[1]) + (v[2] * v[2] + v[3] * v[3]); }
#pragma unroll
              for (int o = 1; o < 64; o <<= 1) ss += __shfl_xor(ss, o);
              if (lane == 0) rst[wave] = 1.0f / sqrtf(ss * (1.0f / DM) + EPS); }
            __syncthreads();
            if (g == 0) pool_rows_sample<2>(p, layer, xs, rst, n, half, c4, g, gn, Dbuf);
            else if (g == 1) pool_rows_sample<4>(p, layer, xs, rst, n, half, c4, g, gn, Dbuf);
            else if (g == 2) pool_rows_sample<8>(p, layer, xs, rst, n, half, c4, g, gn, Dbuf);
            else pool_rows_sample<16>(p, layer, xs, rst, n, half, c4, g, gn, Dbuf);
        }
        __syncthreads();
    }
}

__device__ __forceinline__ void phase_prep(const Params& p, LAS unsigned char* lds) {
    const int tid = opaque_tid(), lane = tid & 63, wave = tid >> 6;
    const int gw = blockIdx.x * NWAVES + wave, NGW = gridDim.x * NWAVES;
    const size_t gt = (size_t)blockIdx.x * NTHREADS + tid, NGT = (size_t)gridDim.x * NTHREADS;
    prep_weights(p, lds, gw, NGW, wave, lane);
    { float* ssq = (float*)(p.ws + WS_SSQ); for (size_t i = gt; i < (size_t)8 * MT; i += NGT) ssq[i] = 0.f; }
    { float* rc = (float*)(p.ws + WS_ROPE); float* rs = rc + 4104 * 32;
      for (size_t i = gt; i < (size_t)4104 * 32; i += NGT) { const int pi = (int)(i >> 5), f = (int)(i & 31); const int pos = pi < SEQ ? pi : 8192 + (pi - SEQ);
          const double turns = (double)pos * INV_FREQ[f] * 0.15915494309189535; const double fr = turns - floor(turns);
          const float a = (float)(fr * 6.283185307179586); rc[i] = __builtin_amdgcn_cosf((float)fr); rs[i] = __builtin_amdgcn_sinf((float)fr); } }
    pool_prep(p, 0, lds);
}

__device__ __forceinline__ void phase_merge(const Params& p) {
    const bf16_t* OG = (const bf16_t*)(p.ws + WS_OG); const float* LSE = (const float*)(p.ws + WS_LSE); bf16_t* OB = (bf16_t*)(p.ws + WS_OB);
    const size_t gt = (size_t)blockIdx.x * NTHREADS + opaque_tid(), NGT = (size_t)gridDim.x * NTHREADS;
    for (size_t i = gt; i < (size_t)MP * 128; i += NGT) {
        const size_t row = i >> 7; const int ch = (int)(i & 127), h = ch >> 3;
        const float l0 = LSE[(0 * (size_t)MP + row) * 16 + h], l1 = LSE[(1 * (size_t)MP + row) * 16 + h], l2 = LSE[(2 * (size_t)MP + row) * 16 + h];
        const float mx = fmaxf(l0, fmaxf(l1, l2));
        float w0 = __builtin_amdgcn_exp2f(l0 - mx), w1 = __builtin_amdgcn_exp2f(l1 - mx), w2 = __builtin_amdgcn_exp2f(l2 - mx);
        const float inv = 1.0f / (w0 + w1 + w2); w0 *= inv; w1 *= inv; w2 *= inv;
        const u32x4 a = *(const u32x4*)(OG + (0 * (size_t)MP + row) * DM + ch * 8), b = *(const u32x4*)(OG + (1 * (size_t)MP + row) * DM + ch * 8), c = *(const u32x4*)(OG + (2 * (size_t)MP + row) * DM + ch * 8);
        u32x4 o;
#pragma unroll
        for (int e = 0; e < 4; ++e) {
            const float lo = w0 * __uint_as_float(a[e] << 16) + w1 * __uint_as_float(b[e] << 16) + w2 * __uint_as_float(c[e] << 16);
            const float hi = w0 * __uint_as_float(a[e] & 0xffff0000u) + w1 * __uint_as_float(b[e] & 0xffff0000u) + w2 * __uint_as_float(c[e] & 0xffff0000u);
            o[e] = pk_bf16(lo, hi);
        }
        *(u32x4*)(OB + row * DM + ch * 8) = o;
    }
}

struct AttnGeom { int dil, r, c, rL; size_t base, lbase, hbase; };
__device__ __forceinline__ AttnGeom attn_geom(int u) {
    const int j5 = (u >> 3) & 31, rc = j5 & 15, h = 2 * (u & 7) + (j5 >> 4), b = (u >> 8) & 3, g = u >> 10;
    AttnGeom G; G.dil = 1 << (2 * g); G.r = rc & (G.dil - 1); G.c = rc >> (2 * g); G.rL = G.r << (12 - 2 * g);
    G.base = ((size_t)g * MP + (size_t)b * SEQ) * DM + h * 64; G.lbase = ((size_t)g * MP + (size_t)b * SEQ) * 16 + h;
    G.hbase = (size_t)((g * 4 + b) * 16 + h) * SEQ * 64; return G;
}
__device__ __forceinline__ void attn_load(const Params& p, int u, int tid, u32x4 (&kreg)[6], u32x4 (&vreg)[6]) {
    const AttnGeom G = attn_geom(u);
    const bf16_t* Kg = (const bf16_t*)(p.ws + WS_KB) + G.hbase; const bf16_t* Vg = (const bf16_t*)(p.ws + WS_VB) + G.hbase;
    const int ch = tid & 7;
#pragma unroll
    for (int k = 0; k < 6; ++k) {
        const int i = (tid >> 3) + 64 * k, kl = 256 * G.c - 128 + i;
        u32x4 kv = {0u, 0u, 0u, 0u}, vv = {0u, 0u, 0u, 0u};
        if (kl >= 0) { const size_t ro = (size_t)(G.rL + kl) * 64 + ch * 8; kv = *(const u32x4*)(Kg + ro); vv = *(const u32x4*)(Vg + ro); }
        kreg[k] = kv; vreg[k] = vv;
    }
}
__device__ __forceinline__ void attn_load_q(const Params& p, int u, int tid, bf16x8 (&qf)[4]) {
    const AttnGeom G = attn_geom(u);
    const bf16_t* Qg = (const bf16_t*)(p.ws + WS_QB) + G.hbase;
    const int lane = tid & 63, wave = tid >> 6, qi = lane & 31, hi = lane >> 5;
    const size_t qro = (size_t)(G.rL + 256 * G.c + 32 * wave + qi) * 64;
#pragma unroll
    for (int d0 = 0; d0 < 4; ++d0) qf[d0] = *(const bf16x8*)(Qg + qro + d0 * 16 + hi * 8);
}
__device__ __forceinline__ void attn_stage(int tid, LAS unsigned char* lds, const u32x4 (&kreg)[6], const u32x4 (&vreg)[6]) {
    const int ch = tid & 7;
#pragma unroll
    for (int k = 0; k < 6; ++k) {
        const int i = (tid >> 3) + 64 * k;
        *(LAS u32x4*)(lds + i * 128 + ((ch ^ ((i >> 1) & 7)) << 4)) = kreg[k];
        *(LAS u32x4*)(lds + 49152 + i * 128 + ((ch ^ (((i >> 1) & 1) << 2)) << 4)) = vreg[k];
    }
}
__device__ __forceinline__ int crow(int r, int hi) { return (r & 3) + 8 * (r >> 2) + 4 * hi; }
__device__ __forceinline__ void attn_compute(const Params& p, int u, int tid, LAS unsigned char* lds, const bf16x8 (&qf)[4]) {
    const int lane = tid & 63, wave = __builtin_amdgcn_readfirstlane(tid >> 6);
    const AttnGeom G = attn_geom(u);
    const int c = G.c;
    bf16_t* Og = (bf16_t*)(p.ws + WS_OG) + G.base; float* Lg = (float*)(p.ws + WS_LSE) + G.lbase;
    LAS unsigned char* ldsK = lds; LAS unsigned char* ldsV = lds + 49152;
    const int qi = lane & 31, hi = lane >> 5;
    const size_t posq = (size_t)(G.r + G.dil * (256 * c + 32 * wave + qi));
    f32x16 o0, o1;
#pragma unroll
    for (int e = 0; e < 16; ++e) { o0[e] = 0.f; o1[e] = 0.f; }
    float mrun = -1e30f, lrun = 0.f;
    const int jstart = (c == 0 && wave < 4) ? 4 - wave : 0;
    for (int jt = jstart; jt < 5; ++jt) {
        const int rowb = 32 * (wave + jt), krow = rowb + qi;
        f32x16 s;
#pragma unroll
        for (int e = 0; e < 16; ++e) s[e] = 0.f;
#pragma unroll
        for (int d0 = 0; d0 < 4; ++d0) { const int ch = 2 * d0 + hi;
            const bf16x8 kf = *(const LAS bf16x8*)(ldsK + krow * 128 + ((ch ^ ((krow >> 1) & 7)) << 4));
            s = __builtin_amdgcn_mfma_f32_32x32x16_bf16(kf, qf[d0], s, 0, 0, 0); }
        if (jt == 0) {
#pragma unroll
            for (int e = 0; e < 16; ++e) if (crow(e, hi) < qi) s[e] = -1e30f;
        }
        if (jt == 4) {
#pragma unroll
            for (int e = 0; e < 16; ++e) if (crow(e, hi) > qi) s[e] = -1e30f;
        }
        float mx = s[0];
#pragma unroll
        for (int e = 1; e < 16; ++e) mx = fmaxf(mx, s[e]);
        mx = fmaxf(mx, __shfl_xor(mx, 32));
        const float mnew = fmaxf(mrun, mx), alpha = __builtin_amdgcn_exp2f(mrun - mnew);
        float ls = 0.f;
#pragma unroll
        for (int e = 0; e < 16; ++e) { s[e] = __builtin_amdgcn_exp2f(s[e] - mnew); ls += s[e]; }
        lrun = lrun * alpha + ls; mrun = mnew;
#pragma unroll
        for (int e = 0; e < 16; ++e) { o0[e] *= alpha; o1[e] *= alpha; }
#pragma unroll
        for (int ks = 0; ks < 2; ++ks) {
            u32x4 pw; pw.x = pk_bf16(s[8 * ks + 0], s[8 * ks + 1]); pw.y = pk_bf16(s[8 * ks + 2], s[8 * ks + 3]); pw.z = pk_bf16(s[8 * ks + 4], s[8 * ks + 5]); pw.w = pk_bf16(s[8 * ks + 6], s[8 * ks + 7]);
            const bf16x8 pf = __builtin_bit_cast(bf16x8, pw);
            const int vrow = rowb + 16 * ks + 4 * hi + ((lane & 15) >> 2);
#pragma unroll
            for (int d0 = 0; d0 < 2; ++d0) {
                const int chv = 4 * d0 + 2 * ((lane >> 4) & 1) + ((lane & 3) >> 1);
                LAS unsigned char* a1 = ldsV + vrow * 128 + ((chv ^ (((vrow >> 1) & 1) << 2)) << 4) + 8 * (lane & 1);
                const s16x4 lo = __builtin_bit_cast(s16x4, __builtin_amdgcn_ds_read_tr16_b64_v4i16((LAS s16x4*)a1));
                const s16x4 hi4 = __builtin_bit_cast(s16x4, __builtin_amdgcn_ds_read_tr16_b64_v4i16((LAS s16x4*)(a1 + 8 * 128)));
                const bf16x8 vf = {lo[0], lo[1], lo[2], lo[3], hi4[0], hi4[1], hi4[2], hi4[3]};
                if (d0 == 0) o0 = __builtin_amdgcn_mfma_f32_32x32x16_bf16(vf, pf, o0, 0, 0, 0);
                else o1 = __builtin_amdgcn_mfma_f32_32x32x16_bf16(vf, pf, o1, 0, 0, 0);
            }
        }
    }
    lrun += __shfl_xor(lrun, 32);
    const float inv = 1.0f / lrun;
    LAS unsigned char* stg = lds + 98304 + wave * 4096;
#pragma unroll
    for (int a = 0; a < 4; ++a) {
        u32x2 w0, w1;
        w0.x = pk_bf16(o0[4 * a] * inv, o0[4 * a + 1] * inv); w0.y = pk_bf16(o0[4 * a + 2] * inv, o0[4 * a + 3] * inv);
        w1.x = pk_bf16(o1[4 * a] * inv, o1[4 * a + 1] * inv); w1.y = pk_bf16(o1[4 * a + 2] * inv, o1[4 * a + 3] * inv);
        *(LAS u32x2*)(stg + qi * 128 + (((a) ^ (qi & 7)) << 4) + 8 * hi) = w0;
        *(LAS u32x2*)(stg + qi * 128 + (((4 + a) ^ (qi & 7)) << 4) + 8 * hi) = w1;
    }
    asm volatile("s_waitcnt lgkmcnt(0)" ::: "memory");
#pragma unroll
    for (int i = 0; i < 4; ++i) {
        const int row = i * 8 + (lane >> 3), ch = lane & 7;
        const u32x4 v = *(const LAS u32x4*)(stg + row * 128 + ((ch ^ (row & 7)) << 4));
        const size_t pr = (size_t)(G.r + G.dil * (256 * c + 32 * wave + row));
        *(u32x4*)(Og + pr * DM + ch * 8) = v;
    }
    if (hi == 0) Lg[posq * 16] = mrun + __builtin_amdgcn_logf(lrun);
}

__device__ __forceinline__ f32x4 bf4_to_f32(u32x2 w) { f32x4 r; r[0] = __uint_as_float(w.x << 16); r[1] = __uint_as_float(w.x & 0xffff0000u); r[2] = __uint_as_float(w.y << 16); r[3] = __uint_as_float(w.y & 0xffff0000u); return r; }
struct SampState { float m, l; f32x4 o; };
__device__ __forceinline__ void sample_load(const Params& p, int u, int bi, int tid, u32x2 (&kk)[11], u32x2 (&vv)[11], f32x4& q4) {
    const int lane = tid & 63, t = tid >> 6, n = u >> 4, h = u & 15, kq = lane >> 4, dq = lane & 15, g = bi / 3, ci = bi - 3 * g;
    const int hist = 128 << (2 * g), dil = 1 << (2 * g);
    const bf16_t* CK = (const bf16_t*)(p.ws + WS_CK); const bf16_t* CV = (const bf16_t*)(p.ws + WS_CV);
    const size_t cb = pg8::ckv_off(g, n, h, 0) + 4 * dq;
    q4 = *(const f32x4*)((const float*)(p.ws + WS_QS) + (size_t)(n * 8 + t) * 3072 + (g * 16 + h) * 64 + 4 * dq);
#pragma unroll
    for (int i = 0; i < 11; ++i) {
        const int j = 4 * (11 * ci + i) + kq, jc = j <= 128 ? j : 128;
        const int idxc = g == 2 ? (128 - jc) * 8 + t : hist + t - dil * jc;
        kk[i] = *(const u32x2*)(CK + cb + (size_t)idxc * 64); vv[i] = *(const u32x2*)(CV + cb + (size_t)idxc * 64);
    }
}
__device__ __forceinline__ void sample_math(int bi, int tid, const u32x2 (&kk)[11], const u32x2 (&vv)[11], const f32x4 q4, SampState& S) {
    const int kq = (tid & 63) >> 4, ci = bi % 3;
    float m = S.m, l = S.l; f32x4 o = S.o;
#pragma unroll
    for (int i = 0; i < 11; ++i) {
        const int j = 4 * (11 * ci + i) + kq;
        const f32x4 k4 = bf4_to_f32(kk[i]), v4 = bf4_to_f32(vv[i]);
        float s = (q4[0] * k4[0] + q4[1] * k4[1]) + (q4[2] * k4[2] + q4[3] * k4[3]);
        s += __shfl_xor(s, 1); s += __shfl_xor(s, 2); s += __shfl_xor(s, 4); s += __shfl_xor(s, 8);
        if (j > 128) s = -1e30f;
        const float mnew = fmaxf(m, s), alpha = __builtin_amdgcn_exp2f(m - mnew), pp = __builtin_amdgcn_exp2f(s - mnew);
        l = l * alpha + pp; o = o * alpha + v4 * pp; m = mnew;
    }
    S.m = m; S.l = l; S.o = o;
}
__device__ __forceinline__ void sample_finish(const Params& p, int u, int tid, SampState& S) {
    const int lane = tid & 63, t = tid >> 6, n = u >> 4, h = u & 15, kq = lane >> 4, dq = lane & 15;
    float m = S.m, l = S.l; f32x4 o = S.o;
    float M = fmaxf(m, __shfl_xor(m, 16)); M = fmaxf(M, __shfl_xor(M, 32));
    const float f = __builtin_amdgcn_exp2f(m - M); l *= f; o = o * f;
    l += __shfl_xor(l, 16); l += __shfl_xor(l, 32);
#pragma unroll
    for (int e = 0; e < 4; ++e) { float x = o[e]; x += __shfl_xor(x, 16); x += __shfl_xor(x, 32); o[e] = x; }
    if (kq == 0) { const float inv = 1.0f / l; u32x2 w; w.x = pk_bf16(o[0] * inv, o[1] * inv); w.y = pk_bf16(o[2] * inv, o[3] * inv);
        *(u32x2*)((bf16_t*)(p.ws + WS_OB) + (size_t)(MP + n * 8 + t) * DM + h * 64 + 4 * dq) = w; }
    S.m = -1e30f; S.l = 0.f; S.o = (f32x4){0.f, 0.f, 0.f, 0.f};
}
__device__ __forceinline__ void phase_attn(const Params& p, LAS unsigned char* lds, int dup) {
    const int tid = opaque_tid();
    int su = blockIdx.x, sb = 0;
    SampState S; S.m = -1e30f; S.l = 0.f; S.o = (f32x4){0.f, 0.f, 0.f, 0.f};
    int u = blockIdx.x;
    u32x4 kreg[6], vreg[6]; bf16x8 qf[4];
    if (u < 3072) { attn_load(p, u, tid, kreg, vreg); attn_load_q(p, u, tid, qf); }
    for (; u < 3072; u += gridDim.x) {
        attn_stage(tid, lds, kreg, vreg);
        __syncthreads();
        const bool hs = su < 512;
        u32x2 kk[11], vv[11]; f32x4 q4;
        if (hs) sample_load(p, su, sb, tid, kk, vv, q4);
        const int un = u + gridDim.x;
        if (un < 3072) attn_load(p, un, tid, kreg, vreg);
        attn_compute(p, u, tid, lds, qf);
        if (un < 3072) attn_load_q(p, un, tid, qf);
        if (hs) { sample_math(sb, tid, kk, vv, q4, S); if (++sb == 9) { sample_finish(p, su, tid, S); sb = 0; su += gridDim.x; } }
        __syncthreads();
    }
    if (su < 512) {
        u32x2 ka[11], va[11], kb[11], vb[11]; f32x4 qa, qb;
        sample_load(p, su, sb, tid, ka, va, qa);
        for (;;) {
            int su2 = su, sb2 = sb + 1; if (sb2 == 9) { sb2 = 0; su2 += gridDim.x; }
            const bool more = su2 < 512;
            if (more) sample_load(p, su2, sb2, tid, kb, vb, qb);
            sample_math(sb, tid, ka, va, qa, S); if (sb == 8) sample_finish(p, su, tid, S);
            if (!more) break;
            su = su2; sb = sb2;
            su2 = su; sb2 = sb + 1; if (sb2 == 9) { sb2 = 0; su2 += gridDim.x; }
            const bool more2 = su2 < 512;
            if (more2) sample_load(p, su2, sb2, tid, ka, va, qa);
            sample_math(sb, tid, kb, vb, qb, S); if (sb == 8) sample_finish(p, su, tid, S);
            if (!more2) break;
            su = su2; sb = sb2;
        }
    }
}

constexpr int NTASK_A = 32 * (16 + 64 + 128), NTASK = NTASK_A + 32 * 128;
struct ChunkGeom { int g, n, R0, hist; };
__device__ __forceinline__ ChunkGeom chunk_geom(int it) {
    ChunkGeom C; int ck;
    if (it < 32 * 16) { C.g = 0; C.n = it >> 4; ck = it & 15; }
    else if (it < 32 * (16 + 64)) { const int r = it - 32 * 16; C.g = 1; C.n = r >> 6; ck = r & 63; }
    else if (it < NTASK_A) { const int r = it - 32 * (16 + 64); C.g = 2; C.n = r >> 7; ck = 2 * (r & 127); }
    else { const int r = it - NTASK_A; C.g = 2; C.n = r >> 7; ck = 2 * (r & 127) + 1; }
    C.hist = 128 << (2 * C.g); C.R0 = 8 * ck; return C;
}
__device__ __forceinline__ void chunk_load(const Params& p, int it, int tid, f32x4 (&v)[8]) {
    const ChunkGeom C = chunk_geom(it);
    const float* cache = C.g == 0 ? p.cache0 : (C.g == 1 ? p.cache1 : p.cache2);
    const f32x4* src = (const f32x4*)(cache + ((size_t)C.n * C.hist + C.R0) * 2048) + tid;
#pragma unroll
    for (int k = 0; k < 8; ++k) v[k] = __builtin_nontemporal_load(src + k * 512);
}
__device__ __forceinline__ void chunk_store(const Params& p, int it, int tid, const f32x4 (&v)[8]) {
    const ChunkGeom C = chunk_geom(it);
    if (C.R0 >= 8) {
        f32x4* dst = (f32x4*)(p.out + (C.g == 0 ? O_KS0 : (C.g == 1 ? O_KS1 : O_KS2)) + ((size_t)C.n * C.hist + C.R0 - 8) * 2048) + tid;
#pragma unroll
        for (int k = 0; k < 8; ++k) __builtin_nontemporal_store(v[k], dst + k * 512);
    }
    if (it < NTASK_A) {
        const int kv = tid >> 8, h = (tid >> 4) & 15, d4 = tid & 15;
        const int idxc0 = C.g == 2 ? (C.R0 >> 4) * 8 : C.R0;
        bf16_t* cp = (bf16_t*)(p.ws + (kv ? WS_CV : WS_CK)) + pg8::ckv_off(C.g, C.n, h, idxc0) + 4 * d4;
#pragma unroll
        for (int k = 0; k < 8; ++k) { u32x2 w; w.x = pk_bf16(v[k][0], v[k][1]); w.y = pk_bf16(v[k][2], v[k][3]); *(u32x2*)(cp + k * 64) = w; }
    }
}
__device__ __forceinline__ void steal_work(const Params& p, LAS unsigned char* lds, int k, unsigned mand) {
    unsigned* ctl = (unsigned*)(p.ws + WS_CTL);
    const int tid = opaque_tid();
    LAS int* flag = (LAS int*)lds;
    __syncthreads();
    if (k >= 0 && tid == 0) atomicAdd(ctl + 64 + 16 * k, 1u);
    for (;;) {
        if (tid == 0) {
            int t0 = -1, t1 = -1; bool go = true, forced = k < 0;
            if (k >= 0) go = __hip_atomic_load(ctl + 64 + 16 * k, __ATOMIC_RELAXED, __HIP_MEMORY_SCOPE_AGENT) < gridDim.x;
            if (!go && mand) { go = __hip_atomic_load(ctl, __ATOMIC_RELAXED, __HIP_MEMORY_SCOPE_AGENT) < mand; forced = go; }
            if (go) { const unsigned nt = forced ? 2u : 1u; const unsigned tk = atomicAdd(ctl, nt); if (tk < (unsigned)NTASK) t0 = (int)tk; if (nt == 2u && tk + 1u < (unsigned)NTASK) t1 = (int)(tk + 1u); }
            flag[0] = t0; flag[1] = t1;
        }
        __syncthreads();
        const int t0 = flag[0], t1 = flag[1];
        __syncthreads();
        if (t0 < 0) break;
        f32x4 va[8];
        chunk_load(p, t0, tid, va);
        if (t1 >= 0) { f32x4 vb[8]; chunk_load(p, t1, tid, vb); chunk_store(p, t0, tid, va); chunk_store(p, t1, tid, vb); }
        else chunk_store(p, t0, tid, va);
    }
}

#define XB_TMO      128
#define XB_XCNT(j)  (256  + 64 * (j))
#define XB_XSUB(j)  (1280 + 64 * (j))
#define XB_XGEN(j)  (2304 + 64 * (j))
#define XB_TOP      3328
#define XB_TOPGEN   3392
#define XCD_BAR_WORDS 3456
#define XB_SPIN_CAP (1u << 18)

__device__ __forceinline__ unsigned xb_ld(unsigned* p)              { return __hip_atomic_load(p, __ATOMIC_RELAXED, __HIP_MEMORY_SCOPE_AGENT); }
__device__ __forceinline__ unsigned xb_add(unsigned* p, unsigned v) { return __hip_atomic_fetch_add(p, v, __ATOMIC_RELAXED, __HIP_MEMORY_SCOPE_AGENT); }
__device__ __forceinline__ unsigned xb_xcc_id() { return (unsigned)__builtin_amdgcn_s_getreg((3 << 11) | 20) & 0xFu; }
#define XB_SPIN(cond, bar) do { unsigned _sp = 0; while (cond) { __builtin_amdgcn_s_sleep(1); \
    if ((++_sp & 255u) == 0u) { if (xb_ld(&(bar)[XB_TMO])) break; if (_sp > XB_SPIN_CAP) { atomicAdd(&(bar)[XB_TMO], 1u); break; } } } } while (0)

struct XcdBarrier {
    unsigned* bar; unsigned x;
    volatile LAS unsigned* st;
};

__device__ __forceinline__ XcdBarrier xcd_barrier_post(unsigned* bar, volatile LAS unsigned* st) {
    XcdBarrier b; b.bar = bar; b.x = xb_xcc_id(); b.st = st;
    if (threadIdx.x == 0) (void)xb_add(&bar[XB_XCNT(b.x)], 1u);
    return b;
}
__device__ __forceinline__ void xcd_barrier_complete(unsigned* bar, unsigned x, unsigned& nloc, unsigned& nx) {
    const unsigned G = gridDim.x * gridDim.y * gridDim.z;
    unsigned sum, cnt, mine, sp = 0u;
    for (;;) {
        sum = 0u; cnt = 0u; mine = 0u;
#pragma unroll
        for (unsigned j = 0; j < 16; ++j) { const unsigned c = xb_ld(&bar[XB_XCNT(j)]); sum += c; cnt += (c > 0u) ? 1u : 0u; mine = (j == x) ? c : mine; }
        if (sum == G) break;
        __builtin_amdgcn_s_sleep(1);
        if ((++sp & 255u) == 0u) { if (xb_ld(&bar[XB_TMO])) break; if (sp > XB_SPIN_CAP) { atomicAdd(&bar[XB_TMO], 1u); break; } }
    }
    nloc = mine > 0u ? mine : 1u; nx = cnt > 0u ? cnt : 1u;
}

__device__ __forceinline__ void xcd_barrier(const XcdBarrier& b) {
    asm volatile("s_waitcnt vmcnt(0)" ::: "memory");
    __syncthreads();
    if (threadIdx.x == 0) {
        unsigned* bar = b.bar;
        __builtin_amdgcn_s_waitcnt(0);
        unsigned nloc = b.st[0], nx = b.st[1];
        if (nloc == 0u) { xcd_barrier_complete(bar, b.x, nloc, nx); b.st[0] = nloc; b.st[1] = nx; }
        const unsigned old = xb_add(&bar[XB_XSUB(b.x)], 1u);
        const unsigned gen = old / nloc;
        if (old + 1u == (gen + 1u) * nloc) {
            __builtin_amdgcn_fence(__ATOMIC_RELEASE, "agent");
            asm volatile("s_waitcnt vmcnt(0)" ::: "memory");
            const unsigned og = xb_add(&bar[XB_TOP], 1u);
            const unsigned tg = og / nx;
            if (og + 1u == (tg + 1u) * nx) xb_add(&bar[XB_TOPGEN], 1u);
            else XB_SPIN(xb_ld(&bar[XB_TOPGEN]) == tg, bar);
            __builtin_amdgcn_fence(__ATOMIC_ACQUIRE, "agent");
            xb_add(&bar[XB_XGEN(b.x)], 1u);
            asm volatile("s_waitcnt vmcnt(0)" ::: "memory");
        } else {
            XB_SPIN(xb_ld(&bar[XB_XGEN(b.x)]) == gen, bar);
            __builtin_amdgcn_fence(__ATOMIC_ACQUIRE, "agent");
            asm volatile("s_waitcnt vmcnt(0)" ::: "memory");
        }
    }
    __syncthreads();
}

__device__ __forceinline__ void seam_barrier(const Params& p, int k) {
    unsigned* w = (unsigned*)(p.ws + WS_CTL) + 3072 + 16 * k;
    __syncthreads();
    if (opaque_tid() == 0) {
        __builtin_amdgcn_fence(__ATOMIC_RELEASE, "agent");
        asm volatile("s_waitcnt vmcnt(0)" ::: "memory");
        __hip_atomic_fetch_add(w, 1u, __ATOMIC_RELAXED, __HIP_MEMORY_SCOPE_AGENT);
        unsigned spins = 0;
        while (__hip_atomic_load(w, __ATOMIC_RELAXED, __HIP_MEMORY_SCOPE_AGENT) < gridDim.x) { __builtin_amdgcn_s_sleep(1); if (++spins > (1u << 24)) break; }
        __builtin_amdgcn_fence(__ATOMIC_ACQUIRE, "agent");
        asm volatile("s_waitcnt vmcnt(0)" ::: "memory");
    }
    __syncthreads();
}

constexpr int NSTEPS = 20;
#ifndef PROBE_DUP_MASK
#define PROBE_DUP_MASK 0u
#endif
__global__ void __launch_bounds__(NTHREADS, 2) yoco_fwd(Params p) {
    extern __shared__ __attribute__((aligned(16))) unsigned char lds_raw[];
    LAS unsigned char* lds = (LAS unsigned char*)lds_raw;
    cg::grid_group grid = cg::this_grid();
    volatile LAS unsigned* xst = (volatile LAS unsigned*)(lds + 131072 + 64);
    if (threadIdx.x == 0) { xst[0] = 0u; xst[1] = 0u; }
    __syncthreads();
    const XcdBarrier xbar = xcd_barrier_post((unsigned*)(p.ws + WS_CTL) + 4096, xst);
    grid.sync();
    unsigned char* ws = p.ws;
    float* X = p.out + O_YP;
    bf16_t* XB = (bf16_t*)(ws + WS_XB); bf16_t* H = (bf16_t*)(ws + WS_H); float* SSQ = (float*)(ws + WS_SSQ);
    const float* ropec = (const float*)(ws + WS_ROPE); const float* ropes = ropec + 4104 * 32;
    const int G = gridDim.x, c = blockIdx.x;
#pragma unroll 1
    for (int st2 = 2 * p.lo; st2 < 2 * p.hi; ++st2) {
        const int st = st2 >> 1;
        if ((st2 & 1) && !((PROBE_DUP_MASK >> st) & 1u)) continue;
        int kind, layer = 0, ssq_in = 0, ssq_out = -1;
        switch (st) {
            case 0: kind = 0; break;
            case 1: kind = 1; layer = 0; ssq_out = 0; break;
            case 2: kind = 2; layer = 0; ssq_in = 0; break;
            case 3: kind = 3; layer = 0; break;
            case 4: kind = 4; break;
            case 5: kind = 1; layer = 1; ssq_out = 1; break;
            case 6: kind = 2; layer = 1; ssq_in = 1; break;
            case 7: kind = 3; layer = 1; ssq_out = 2; break;
            case 8: kind = 5; ssq_in = 2; break;
            case 9: kind = 6; break;
            case 10: kind = 7; break;
            case 11: kind = 8; layer = 0; ssq_out = 3; break;
            case 12: kind = 2; layer = 2; ssq_in = 3; break;
            case 13: kind = 3; layer = 2; ssq_out = 4; break;
            case 14: kind = 9; ssq_in = 4; break;
            case 15: kind = 6; break;
            case 16: kind = 7; break;
            case 17: kind = 8; layer = 1; ssq_out = 5; break;
            case 18: kind = 2; layer = 3; ssq_in = 5; break;
            default: kind = 3; layer = 3; break;
        }
#ifdef PROBE_EMPTY_DUP
        if (st2 & 1) kind = -1;
#endif
        if (kind < 0) {}
        else if (kind == 0) phase_prep(p, lds);
        else if (kind == 4) pool_prep(p, 1, lds);
        else if (kind == 6) phase_attn(p, lds, st2 & 1);
        else if (kind == 7) phase_merge(p);
        else if (kind == 2) {
            unsigned* scnt = (unsigned*)(ws + WS_CTL) + 2048 + 16 * layer;
            if (c < G - 8) {
                pg8::Gemm g{XB, (const bf16_t*)(ws + WS_WGU) + (size_t)layer * 2 * FF * DM, MT, 2 * FF, DM};
                pg8::StaticOrder S; S.init(MP, 2 * FF, G - 8, c, 3); S.cnt = scnt;
                pg8::EpiGU E{SSQ + (size_t)ssq_in * MT, H};
                pg8::gemm_phase<pg8::EpiGU, pg8::StaticOrder, true, true>(lds, g, S, E);
            } else if (c < G - 4) {
                if (opaque_tid() == 0) { while (__hip_atomic_load(scnt, __ATOMIC_RELAXED, __HIP_MEMORY_SCOPE_AGENT) < 22u) __builtin_amdgcn_s_sleep(32); }
                __syncthreads();
                __builtin_amdgcn_fence(__ATOMIC_ACQUIRE, "agent");
                const int so = layer == 1 ? 2 : (layer == 2 ? 4 : -1);
                pg8::Gemm g{H, (const bf16_t*)(ws + WS_WDN) + (size_t)layer * DM * FF, MT, DM, FF};
                pg8::StaticOrder S; S.init(MP, DM, G, c - (G - 8), 4);
                pg8::EpiResid E; E.X = X; E.scale = nullptr; E.xin_p = X; E.xin_s = X + (size_t)MP * DM;
                E.xb = so >= 0 ? XB : nullptr; E.ssq = so >= 0 ? SSQ + (size_t)so * MT : nullptr;
                pg8::gemm_phase<pg8::EpiResid, pg8::StaticOrder, true, true>(lds, g, S, E);
            }
        } else if (kind == 5 || kind == 9) {
            pg8::Gemm g{XB, (const bf16_t*)(ws + (kind == 5 ? WS_WKVQ : WS_WQ1)), MT, kind == 5 ? 9216 : 3072, DM};
            pg8::StaticOrder S; S.init(MT, g.N, G, c, 0);
            pg8::EpiQKV E{SSQ + (size_t)ssq_in * MT, kind == 5 ? 0 : 24, p.k_norm, p.q_norm + (kind == 5 ? 0 : 192), ropec, ropes,
                          (bf16_t*)(ws + WS_KB), (bf16_t*)(ws + WS_VB), (bf16_t*)(ws + WS_QB), (float*)(ws + WS_QS), p.out, (bf16_t*)(ws + WS_CK), (bf16_t*)(ws + WS_CV)};
            pg8::gemm_phase<pg8::EpiQKV, pg8::StaticOrder, true, true>(lds, g, S, E);
        } else {
            pg8::Gemm g; pg8::StaticOrder S; pg8::EpiResid E;
            E.X = X; E.scale = nullptr; E.xin_p = X; E.xin_s = X + (size_t)MP * DM;
            E.xb = ssq_out >= 0 ? XB : nullptr; E.ssq = ssq_out >= 0 ? SSQ + (size_t)ssq_out * MT : nullptr;
            if (kind == 1) {
                g = pg8::Gemm{(const bf16_t*)(ws + WS_DBUF), (const bf16_t*)(ws + WS_WPOOL) + (size_t)layer * 4 * 65536, 4 * MT, 1024, 256};
                S.init(MT, 1024, G, c, 1); E.scale = p.pool_scale + layer * DM;
                if (layer == 0) { E.xin_p = p.x_prompt; E.xin_s = p.x_sample; }
            } else if (kind == 3) {
                g = pg8::Gemm{H, (const bf16_t*)(ws + WS_WDN) + (size_t)layer * DM * FF, MP, DM, FF};
                S.init(MP, DM, G, c, 0);
            } else {
                g = pg8::Gemm{(const bf16_t*)(ws + WS_OB), (const bf16_t*)(ws + WS_WO) + (size_t)layer * DM * DM, MT, DM, DM};
                S.init(MT, DM, G, c, 0);
            }
            pg8::gemm_phase<pg8::EpiResid, pg8::StaticOrder, true, true>(lds, g, S, E);
        }
        if (st2 + 2 < 2 * p.hi) {
            if (kind == 1 || kind == 2 || kind == 5 || kind == 8 || kind == 9) steal_work(p, lds, st2, st == 8 ? (unsigned)NTASK_A : 0u);
            xcd_barrier(xbar);
        }
    }
    steal_work(p, lds, -1, 0u);
}

extern "C" void kernel_launch(void* const* d_in, const int* in_sizes, int n_in, void* d_out, int out_size, void* d_ws, size_t ws_size, hipStream_t stream) {
    static int grid = 0;
    if (grid == 0) {
        if (n_in != 20 || (size_t)out_size != O_END || ws_size < WS_END) { fprintf(stderr, "kernel_launch: unexpected shapes: n_in %d out %d ws %zu (need %zu)\n", n_in, out_size, ws_size, (size_t)WS_END); grid = -1; return; }
        int dev = 0, cus = 0, per_cu = 0;
        hipGetDevice(&dev); hipDeviceGetAttribute(&cus, hipDeviceAttributeMultiprocessorCount, dev);
        if (hipFuncSetAttribute((const void*)yoco_fwd, hipFuncAttributeMaxDynamicSharedMemorySize, LDS_BYTES) != hipSuccess) { fprintf(stderr, "kernel_launch: hipFuncSetAttribute failed\n"); grid = -1; return; }
        if (hipOccupancyMaxActiveBlocksPerMultiprocessor(&per_cu, (const void*)yoco_fwd, NTHREADS, LDS_BYTES) != hipSuccess || per_cu < 1) { fprintf(stderr, "kernel_launch: occupancy query failed (%d)\n", per_cu); (void)hipGetLastError(); per_cu = 1; }
        grid = cus * per_cu;
    }
    if (grid < 0) return;
    Params p{};
    const float** pp = (const float**)&p;
    for (int i = 0; i < 20; ++i) pp[i] = (const float*)d_in[i];
    p.out = (float*)d_out; p.ws = (unsigned char*)d_ws; p.lo = 0; p.hi = NSTEPS;
    if (hipMemsetAsync((unsigned char*)d_ws + WS_CTL, 0, 32768, stream) != hipSuccess) { fprintf(stderr, "kernel_launch: memset failed\n"); return; }
    void* args[] = {&p};
    hipError_t e = hipLaunchCooperativeKernel((const void*)yoco_fwd, dim3(grid), dim3(NTHREADS), args, LDS_BYTES, stream);
    if (e != hipSuccess) fprintf(stderr, "kernel_launch: cooperative launch failed: %s (grid %d)\n", hipGetErrorString(e), grid);
}
```

```cpp
#include <hip/hip_runtime.h>
#include <hip/hip_cooperative_groups.h>
#include <cstdio>
#include <cstdint>
namespace cg = cooperative_groups;

constexpr int MP = 16384, MS = 256, MT = MP + MS, DM = 1024, FF = 2816, SEQ = 4096, NTM = MT / 256;
constexpr float EPS = 1e-6f;
constexpr float C2 = 0.125f * 1.4426950408889634f;
constexpr size_t O_YP = 0, O_YS = O_YP + (size_t)MP * DM, O_PP = O_YS + (size_t)MS * DM, O_PS = O_PP + 4 * 2 * 15 * 1024,
                 O_KP0 = O_PS + 32 * 2 * 15 * 1024, O_KS0 = O_KP0 + (size_t)4 * 128 * 2048, O_KP1 = O_KS0 + (size_t)32 * 128 * 2048,
                 O_KS1 = O_KP1 + (size_t)4 * 512 * 2048, O_KP2 = O_KS1 + (size_t)32 * 512 * 2048, O_KS2 = O_KP2 + (size_t)4 * 2048 * 2048,
                 O_END = O_KS2 + (size_t)32 * 2048 * 2048;
constexpr size_t AL(size_t x) { return (x + 65535) & ~(size_t)65535; }
constexpr size_t WS_WPOOL = 0;
constexpr size_t WS_WGU = AL(WS_WPOOL + (size_t)8 * 65536 * 2);
constexpr size_t WS_WDN = AL(WS_WGU + (size_t)4 * 5632 * 1024 * 2);
constexpr size_t WS_WKVQ = AL(WS_WDN + (size_t)4 * 1024 * 2816 * 2);
constexpr size_t WS_WQ1 = AL(WS_WKVQ + (size_t)9216 * 1024 * 2);
constexpr size_t WS_WO = AL(WS_WQ1 + (size_t)3072 * 1024 * 2);
constexpr size_t WS_DBUF = AL(WS_WO + (size_t)2 * 1024 * 1024 * 2);
constexpr size_t WS_XB = AL(WS_DBUF + (size_t)4 * MT * 256 * 2);
constexpr size_t WS_H = AL(WS_XB + (size_t)MT * 1024 * 2);
constexpr size_t WS_KB = AL(WS_H + (size_t)MT * FF * 2);
constexpr size_t WS_VB = AL(WS_KB + (size_t)3 * MP * 1024 * 2);
constexpr size_t WS_QB = AL(WS_VB + (size_t)3 * MP * 1024 * 2);
constexpr size_t WS_OG = AL(WS_QB + (size_t)3 * MP * 1024 * 2);
constexpr size_t WS_LSE = AL(WS_OG + (size_t)3 * MP * 1024 * 2);
constexpr size_t WS_OB = AL(WS_LSE + (size_t)3 * MP * 16 * 4);
constexpr size_t WS_QS = AL(WS_OB + (size_t)MT * 1024 * 2);
constexpr size_t WS_SSQ = AL(WS_QS + (size_t)256 * 3072 * 4);
constexpr size_t WS_ROPE = AL(WS_SSQ + (size_t)8 * MT * 4);
constexpr size_t WS_CTL = AL(WS_ROPE + (size_t)2 * 4104 * 32 * 4);
constexpr size_t CKV_ROWS = 136 + 520 + 1032;
constexpr size_t WS_CK = AL(WS_CTL + 32768);
constexpr size_t WS_CV = AL(WS_CK + (size_t)512 * CKV_ROWS * 64 * 2);
constexpr size_t WS_END = AL(WS_CV + (size_t)512 * CKV_ROWS * 64 * 2);

struct Params {
    const float *x_prompt, *x_sample, *state_pool, *cache0, *cache1, *cache2, *a_norm, *pool_w, *pool_scale, *kv_norm, *w_kv, *k_norm, *b_norm, *w_q, *q_norm, *w_o,
        *ffn_norm, *w_gate, *w_up, *w_down;
    float* out; unsigned char* ws; int lo, hi;
};

__device__ __forceinline__ int opaque_tid() { int t = threadIdx.x; asm volatile("" : "+v"(t)); return t; }
namespace pg8 {
#define PG8_LAS __attribute__((address_space(3)))
typedef unsigned short bf16_t;
typedef short bf16x8 __attribute__((ext_vector_type(8)));
typedef float f32x4 __attribute__((ext_vector_type(4)));
typedef unsigned u32x4 __attribute__((ext_vector_type(4)));
typedef unsigned u32x2 __attribute__((ext_vector_type(2)));
constexpr int BM = 256, BK = 64, HALF = 128, HTB = HALF * BK * 2  , STAGE_BYTES = 8 * HTB, NXCD = 8, WGM = 8;

__host__ __device__ __forceinline__ int lds_byte(int r, int c) { const int st = (r >> 4) * 2 + (c >> 5), rr = r & 15, cc = c & 31, ob = rr * 64 + cc * 2; return st * 1024 + (ob ^ (((ob >> 9) & 1) << 5)); }
__host__ __device__ __forceinline__ void stage_rc(int b, int& R, int& C) { const int st = b / 1024, sb = b % 1024, swz = sb ^ (((sb >> 9) & 1) << 5); R = (st >> 1) * 16 + swz / 64; C = (st & 1) * 32 + (swz % 64) / 2; }
__host__ __device__ __forceinline__ int perm32(int rho) { const int n = rho >> 4, i = rho & 15; return 8 * (i >> 2) + 4 * n + (i & 3); }

struct Unit { int pm, pn, rowt, colt; };
struct Gemm { const bf16_t* A; const bf16_t* Bt; int M, N, K; };

struct StaticOrder {
    int nM, nN, nwg, G, c, mode; unsigned* cnt;
    __device__ void init(int M, int N, int G_, int c_, int mode_) { nM = M / BM; nN = N / BM; nwg = nM * nN; G = G_; c = c_; mode = mode_; cnt = nullptr; }
    __device__ bool next(int i, Unit& u) const {
        if (mode == 4) { if (i > 0) return false; u.pm = nM; u.pn = c; u.rowt = nM; u.colt = c; return true; }
        const long L = (long)i * G + c;
        int wgid = (int)L, nw = nwg, nm = nM;
        if (mode == 3) {
            if (L >= nwg + nN) return false;
            if (L < nN) { u.pm = nM; u.pn = (int)L; u.rowt = nM; u.colt = (int)L; return true; }
            wgid -= nN;
        } else if (L >= nwg) return false;
        if (mode == 1) { const int g = wgid / NTM, m = wgid % NTM; u.pm = g * NTM + m; u.pn = g; u.rowt = m; u.colt = g; return true; }
        { const int q = nw / NXCD, r = nw % NXCD, xcd = wgid % NXCD, off = wgid / NXCD; wgid = (xcd < r ? xcd * (q + 1) : r * (q + 1) + (xcd - r) * q) + off; }
        const int nig = WGM * nN, gid = wgid / nig, fm = gid * WGM, gsz = (nm - fm) < WGM ? (nm - fm) : WGM;
        u.pm = fm + ((wgid % nig) % gsz); u.pn = (wgid % nig) / gsz; u.rowt = u.pm; u.colt = u.pn; return true;
    }
    __device__ __forceinline__ void a_ready(const Unit&) const {}
    __device__ __forceinline__ void done(const Unit& u) const {
        if (mode == 3 && u.rowt == nM) {
            asm volatile("s_waitcnt vmcnt(0)" ::: "memory");
            __builtin_amdgcn_s_barrier();
            if (threadIdx.x == 0) atomicAdd(cnt, 1u);
        }
    }
};

__device__ __forceinline__ unsigned cvt_pk_bf16(float lo, float hi) { unsigned r; asm volatile("v_cvt_pk_bf16_f32 %0, %1, %2" : "=v"(r) : "v"(lo), "v"(hi)); return r; }


struct EpiResid {
    static constexpr bool PERM = false, AFTER_DRAIN = false;
    const float* xin_p; const float* xin_s; float* X; const float* scale; bf16_t* xb; float* ssq;
    __device__ __forceinline__ void operator()(const f32x4 (&acc)[2][2][4][2], const Unit& u, int wr, int wc, int fr, int fq) const {
        const int colbase = u.colt * BM + wc * 32 + fq * 4;
        f32x4 sc[2][2];
#pragma unroll
        for (int bj = 0; bj < 2; ++bj)
#pragma unroll
            for (int n = 0; n < 2; ++n) sc[bj][n] = scale ? *(const f32x4*)(scale + colbase + bj * HALF + n * 16) : (f32x4){1.f, 1.f, 1.f, 1.f};
#pragma unroll
        for (int ai = 0; ai < 2; ++ai) {
            const int row0 = u.rowt * BM + ai * HALF + wr * 64 + fr;
            const float* xi0 = (row0 < MP) ? xin_p + (size_t)row0 * DM : xin_s + (size_t)(row0 - MP) * DM;
            f32x4 xv[4][2][2];
#pragma unroll
            for (int m = 0; m < 4; ++m)
#pragma unroll
                for (int bj = 0; bj < 2; ++bj)
#pragma unroll
                    for (int n = 0; n < 2; ++n) xv[m][bj][n] = *(const f32x4*)(xi0 + (size_t)m * 16 * DM + colbase + bj * HALF + n * 16);
            asm volatile("" ::: "memory");
#pragma unroll
            for (int m = 0; m < 4; ++m) {
                const int row = row0 + m * 16;
                float* xo = X + (size_t)row * DM; float ss = 0.f;
#pragma unroll
                for (int bj = 0; bj < 2; ++bj)
#pragma unroll
                    for (int n = 0; n < 2; ++n) {
                        const int col = colbase + bj * HALF + n * 16;
                        const f32x4 v = xv[m][bj][n] + acc[ai][bj][m][n] * sc[bj][n];
                        *(f32x4*)(xo + col) = v;
                        if (xb) { u32x2 w; w.x = cvt_pk_bf16(v[0], v[1]); w.y = cvt_pk_bf16(v[2], v[3]); *(u32x2*)(xb + (size_t)row * DM + col) = w; }
                        ss += (v[0] * v[0] + v[1] * v[1]) + (v[2] * v[2] + v[3] * v[3]);
                    }
                if (ssq) { ss += __shfl_xor(ss, 16); ss += __shfl_xor(ss, 32); if (fq == 0) atomicAdd(ssq + row, ss); }
            }
            asm volatile("" ::: "memory");
        }
    }
};

struct EpiGU {
    static constexpr bool PERM = false, AFTER_DRAIN = false;
    const float* ssq; bf16_t* H;
    __device__ __forceinline__ void operator()(const f32x4 (&acc)[2][2][4][2], const Unit& u, int wr, int wc, int fr, int fq) const {
        float rsv[2][4];
#pragma unroll
        for (int ai = 0; ai < 2; ++ai)
#pragma unroll
            for (int m = 0; m < 4; ++m) rsv[ai][m] = ssq[u.rowt * BM + ai * HALF + wr * 64 + m * 16 + fr];
#pragma unroll
        for (int ai = 0; ai < 2; ++ai)
#pragma unroll
            for (int m = 0; m < 4; ++m) {
                const int row = u.rowt * BM + ai * HALF + wr * 64 + m * 16 + fr;
                const float rs = __builtin_amdgcn_rsqf(rsv[ai][m] * (1.0f / DM) + EPS);
#pragma unroll
                for (int bj = 0; bj < 2; ++bj) {
                    const int hcol = u.colt * 128 + bj * 64 + wc * 16 + fq * 4;
                    const f32x4 g = acc[ai][bj][m][0] * rs, up = acc[ai][bj][m][1] * rs; float o[4];
#pragma unroll
                    for (int e = 0; e < 4; ++e) { const float sg = __builtin_amdgcn_rcpf(1.0f + __builtin_amdgcn_exp2f(-1.4426950408889634f * g[e])); o[e] = g[e] * sg * up[e]; }
                    u32x2 w; w.x = cvt_pk_bf16(o[0], o[1]); w.y = cvt_pk_bf16(o[2], o[3]);
                    if (u.rowt == MP / BM) __hip_atomic_store((unsigned long long*)(H + (size_t)row * FF + hcol), ((unsigned long long)w.y << 32) | (unsigned long long)w.x, __ATOMIC_RELAXED, __HIP_MEMORY_SCOPE_AGENT);
                    else *(u32x2*)(H + (size_t)row * FF + hcol) = w;
                }
            }
    }
};

__device__ __forceinline__ size_t hm_off(int g, int row, int h) {
    const int pos = row & (SEQ - 1), b = row >> 12, sh = 2 * g;
    const int sig = ((pos & ((1 << sh) - 1)) << (12 - sh)) + (pos >> sh);
    return ((size_t)((g * 4 + b) * 16 + h) * SEQ + sig) * 64;
}
__device__ __forceinline__ size_t ckv_off(int g, int n, int h, int idxc) {
    const size_t gbase = g == 0 ? 0 : (g == 1 ? (size_t)512 * 136 : (size_t)512 * (136 + 520));
    const int rc = g == 0 ? 136 : (g == 1 ? 520 : 1032);
    return (gbase + (size_t)(n * 16 + h) * rc + idxc) * 64;
}
struct EpiQKV {
    static constexpr bool PERM = false, AFTER_DRAIN = false;
    const float* ssq; int tile_base; const float* k_norm; const float* q_norm; const float* ropec; const float* ropes;
    bf16_t* Kb; bf16_t* Vb; bf16_t* Qb; float* QS; float* out; bf16_t* CK; bf16_t* CV;
    __device__ __forceinline__ void operator()(const f32x4 (&acc)[2][2][4][2], const Unit& u, int wr, int wc, int fr, int fq) const {
        const int tile = u.colt + tile_base, type = tile / 12, G = 4 * (tile % 12) + wc, g = G >> 4, h = G & 15;
        const int hist = 128 << (2 * g);
        const float* gn = (type == 0 ? k_norm : q_norm) + g * 64;
        const size_t okp = g == 0 ? O_KP0 : (g == 1 ? O_KP1 : O_KP2), oks = g == 0 ? O_KS0 : (g == 1 ? O_KS1 : O_KS2);
        f32x4 gA[2], gB[2];
#pragma unroll
        for (int n = 0; n < 2; ++n) { gA[n] = *(const f32x4*)(gn + n * 16 + fq * 4); gB[n] = *(const f32x4*)(gn + 32 + n * 16 + fq * 4); }
#pragma unroll
        for (int ai = 0; ai < 2; ++ai)
#pragma unroll
            for (int mh = 0; mh < 2; ++mh) {
                float sq[2]; f32x4 cs[2][2], sn[2][2];
#pragma unroll
                for (int mm = 0; mm < 2; ++mm) {
                    const int row = u.rowt * BM + ai * HALF + wr * 64 + (2 * mh + mm) * 16 + fr;
                    sq[mm] = ssq[row];
                    if (type != 1) {
                        const int pi = row < MP ? (row & (SEQ - 1)) : SEQ + ((row - MP) & 7);
#pragma unroll
                        for (int n = 0; n < 2; ++n) { cs[mm][n] = *(const f32x4*)(ropec + pi * 32 + n * 16 + fq * 4); sn[mm][n] = *(const f32x4*)(ropes + pi * 32 + n * 16 + fq * 4); }
                    }
                }
                asm volatile("" ::: "memory");
#pragma unroll
                for (int mm = 0; mm < 2; ++mm) {
                    const int m = 2 * mh + mm;
                    const int row = u.rowt * BM + ai * HALF + wr * 64 + m * 16 + fr;
                    const float rs = __builtin_amdgcn_rsqf(sq[mm] * (1.0f / DM) + EPS);
                    f32x4 v[2][2];
#pragma unroll
                    for (int bj = 0; bj < 2; ++bj)
#pragma unroll
                        for (int n = 0; n < 2; ++n) v[bj][n] = acc[ai][bj][m][n] * rs;
                    if (type != 1) {
                        float ss = 0.f;
#pragma unroll
                        for (int bj = 0; bj < 2; ++bj)
#pragma unroll
                            for (int n = 0; n < 2; ++n) ss += (v[bj][n][0] * v[bj][n][0] + v[bj][n][1] * v[bj][n][1]) + (v[bj][n][2] * v[bj][n][2] + v[bj][n][3] * v[bj][n][3]);
                        ss += __shfl_xor(ss, 16); ss += __shfl_xor(ss, 32);
                        float hr = __builtin_amdgcn_rsqf(ss * (1.0f / 64.0f) + EPS);
                        if (type == 2) hr *= C2;
#pragma unroll
                        for (int n = 0; n < 2; ++n) {
                            const f32x4 a = v[0][n] * hr * gA[n], b = v[1][n] * hr * gB[n];
                            v[0][n] = a * cs[mm][n] - b * sn[mm][n]; v[1][n] = b * cs[mm][n] + a * sn[mm][n];
                        }
                    }
#pragma unroll
                    for (int bj = 0; bj < 2; ++bj)
#pragma unroll
                        for (int n = 0; n < 2; ++n) {
                            const int d = bj * 32 + n * 16 + fq * 4; const f32x4 x = v[bj][n];
                            u32x2 w; w.x = cvt_pk_bf16(x[0], x[1]); w.y = cvt_pk_bf16(x[2], x[3]);
                            if (type == 2) {
                                if (row < MP) *(u32x2*)(Qb + hm_off(g, row, h) + d) = w;
                                else *(f32x4*)(QS + (size_t)(row - MP) * 3072 + G * 64 + d) = x;
                            } else {
                                if (row < MP) {
                                    *(u32x2*)((type == 0 ? Kb : Vb) + hm_off(g, row, h) + d) = w;
                                    const int s = row & (SEQ - 1), b = row >> 12;
                                    if (s >= SEQ - hist) *(f32x4*)(out + okp + ((size_t)(b * hist + s - (SEQ - hist)) * 2 + type) * DM + h * 64 + d) = x;
                                } else {
                                    const int q = row - MP, n_ = q >> 3, t = q & 7;
                                    *(f32x4*)(out + oks + ((size_t)(n_ * hist + hist - 8 + t) * 2 + type) * DM + h * 64 + d) = x;
                                    *(u32x2*)((type == 0 ? CK : CV) + ckv_off(g, n_, h, (g == 2 ? 1024 : hist) + t) + d) = w;
                                }
                            }
                        }
                }
                asm volatile("" ::: "memory");
            }
    }
};

template <class Epi, class Sched, bool ALIGN_EPI = false, bool SP2 = false>
__device__ __forceinline__ void gemm_phase(PG8_LAS unsigned char* lds, const Gemm g, const Sched& S, const Epi& E) {
    const int tid = opaque_tid(), wid = __builtin_amdgcn_readfirstlane(tid >> 6), lane = tid & 63, wr = wid >> 2, wc = wid & 3, fr = lane & 15, fq = lane >> 4;
    const int K = g.K, nt = K / BK;
    unsigned voffA[2], voffB[2];
#pragma unroll
    for (int i = 0; i < 2; ++i) { int R, C; stage_rc(tid * 16 + i * 8192, R, C); const int Rb = Epi::PERM ? ((R & ~31) + perm32(R & 31)) : R;
        voffA[i] = (unsigned)(R * K + C) * 2u; voffB[i] = (unsigned)(Rb * K + C) * 2u; }
    const size_t kstep = (size_t)(BK * 2);
    const size_t hstep = (size_t)HALF * K * 2;
    const size_t tstep = 2 * hstep;
    const unsigned ldsw = (unsigned)wid * 1024u;
    const int aoff = lds_byte(wr * 64 + fr, fq * 8), boff = lds_byte(wc * 32 + fr, fq * 8);
#define PG8_SA(b, h) (((b) * 2 + (h)) * HTB)
#define PG8_SB(b, h) ((4 + (b) * 2 + (h)) * HTB)
#define PG8_STAGE(bufoff, gbase, voff) do { _Pragma("unroll") for (int _i = 0; _i < 2; ++_i) \
        __builtin_amdgcn_global_load_lds((const unsigned*)((const char*)(gbase) + (voff)[_i]), (PG8_LAS unsigned*)(lds + (bufoff) + ldsw + _i * 8192), 16, 0, 0); } while (0)
#define PG8_LDA(dst, b, h) do { _Pragma("unroll") for (int m = 0; m < 4; ++m) _Pragma("unroll") for (int k = 0; k < 2; ++k) dst[m][k] = *(const PG8_LAS bf16x8*)(lds + PG8_SA(b, h) + aoff + m * 2048 + k * 1024); } while (0)
#define PG8_LDB(dst, b, h) do { _Pragma("unroll") for (int n = 0; n < 2; ++n) _Pragma("unroll") for (int k = 0; k < 2; ++k) dst[n][k] = *(const PG8_LAS bf16x8*)(lds + PG8_SB(b, h) + boff + n * 2048 + k * 1024); } while (0)
#define PG8_MMA(ai, bj, At, Bt) do { __builtin_amdgcn_s_setprio(1); _Pragma("unroll") for (int m = 0; m < 4; ++m) _Pragma("unroll") for (int n = 0; n < 2; ++n) _Pragma("unroll") for (int k = 0; k < 2; ++k) \
        acc[ai][bj][m][n] = __builtin_amdgcn_mfma_f32_16x16x32_bf16(Bt[n][k], At[m][k], acc[ai][bj][m][n], 0, 0, 0); __builtin_amdgcn_s_setprio(0); } while (0)
#define PG8_WAIT_V(n) asm volatile("s_waitcnt vmcnt(" #n ")" ::: "memory")
#define PG8_WAIT_L(n) asm volatile("s_waitcnt lgkmcnt(" #n ")" ::: "memory")
#define PG8_BAR __builtin_amdgcn_s_barrier()
#define PG8_SCHED __builtin_amdgcn_sched_barrier(0)
    Unit cur, nxt; int ui = 0;
    if (!S.next(0, cur)) return;
    f32x4 acc[2][2][4][2];
#pragma unroll
    for (int a = 0; a < 2; ++a)
#pragma unroll
        for (int b = 0; b < 2; ++b)
#pragma unroll
            for (int m = 0; m < 4; ++m)
#pragma unroll
                for (int n = 0; n < 2; ++n) acc[a][b][m][n] = (f32x4){0.f, 0.f, 0.f, 0.f};
    bf16x8 At[4][2], B0[2][2], B1[2][2];
    const char* cA = (const char*)g.A + (size_t)cur.pm * tstep; const char* cB = (const char*)g.Bt + (size_t)cur.pn * tstep;
    S.a_ready(cur);
    if constexpr (SP2) {
        PG8_STAGE(PG8_SB(0, 0), cB, voffB); PG8_STAGE(PG8_SB(0, 1), cB + hstep, voffB); PG8_STAGE(PG8_SA(0, 0), cA, voffA); PG8_STAGE(PG8_SA(0, 1), cA + hstep, voffA);
        if (wr == 1) PG8_BAR;
        PG8_WAIT_V(2); PG8_BAR;
        PG8_STAGE(PG8_SB(1, 0), cB + kstep, voffB); PG8_STAGE(PG8_SA(1, 0), cA + kstep, voffA); PG8_STAGE(PG8_SB(1, 1), cB + hstep + kstep, voffB);
        PG8_WAIT_V(6); PG8_BAR;
    } else {
        PG8_STAGE(PG8_SB(0, 0), cB, voffB); PG8_STAGE(PG8_SA(0, 0), cA, voffA); PG8_STAGE(PG8_SB(0, 1), cB + hstep, voffB); PG8_STAGE(PG8_SA(0, 1), cA + hstep, voffA);
        if (wr == 1) PG8_BAR;
        PG8_WAIT_V(4); PG8_BAR;
        PG8_STAGE(PG8_SB(1, 0), cB + kstep, voffB); PG8_STAGE(PG8_SA(1, 0), cA + kstep, voffA); PG8_STAGE(PG8_SB(1, 1), cB + hstep + kstep, voffB);
        PG8_WAIT_V(6); PG8_BAR;
    }
    for (;;) {
        const bool has_next = S.next(ui + 1, nxt);
        const char* nA = has_next ? (const char*)g.A + (size_t)nxt.pm * tstep : cA; const char* nB = has_next ? (const char*)g.Bt + (size_t)nxt.pn * tstep : cB;
        for (int t = 0; t < nt; t += 2) {
            const bool last = (t == nt - 2);
            const char* a1 = cA + (size_t)(t + 1) * kstep;
            const char* a2 = last ? nA : cA + (size_t)(t + 2) * kstep; const char* b2 = last ? nB : cB + (size_t)(t + 2) * kstep;
            const char* a3 = a2 + kstep; const char* b3 = b2 + kstep;
            if (last && has_next) S.a_ready(nxt);
            if constexpr (SP2) {
            PG8_LDB(B0, 0, 0); PG8_LDB(B1, 0, 1); PG8_SCHED; PG8_LDA(At, 0, 0); PG8_STAGE(PG8_SA(1, 1), a1 + hstep, voffA);
            PG8_WAIT_V(8); PG8_WAIT_L(0); PG8_BAR; PG8_MMA(0, 0, At, B0); PG8_MMA(0, 1, At, B1); PG8_BAR; PG8_SCHED;
            PG8_LDA(At, 0, 1); PG8_STAGE(PG8_SB(0, 0), b2, voffB); PG8_STAGE(PG8_SB(0, 1), b2 + hstep, voffB); PG8_STAGE(PG8_SA(0, 0), a2, voffA);
            PG8_WAIT_V(8); PG8_WAIT_L(0); PG8_BAR; PG8_MMA(1, 0, At, B0); PG8_MMA(1, 1, At, B1); PG8_BAR; PG8_SCHED;
            PG8_LDB(B0, 1, 0); PG8_LDB(B1, 1, 1); PG8_SCHED; PG8_LDA(At, 1, 0); PG8_STAGE(PG8_SA(0, 1), a2 + hstep, voffA);
            PG8_WAIT_V(8); PG8_WAIT_L(0); PG8_BAR; PG8_MMA(0, 0, At, B0); PG8_MMA(0, 1, At, B1); PG8_BAR; PG8_SCHED;
            PG8_LDA(At, 1, 1); PG8_STAGE(PG8_SB(1, 0), b3, voffB); PG8_STAGE(PG8_SB(1, 1), b3 + hstep, voffB); PG8_STAGE(PG8_SA(1, 0), a3, voffA);
            PG8_WAIT_V(8); PG8_WAIT_L(0); PG8_BAR; PG8_MMA(1, 0, At, B0); PG8_MMA(1, 1, At, B1); PG8_BAR; PG8_SCHED;
            } else {
            PG8_LDB(B0, 0, 0); PG8_SCHED; PG8_LDA(At, 0, 0); PG8_STAGE(PG8_SA(1, 1), a1 + hstep, voffA);
            PG8_WAIT_L(8); PG8_BAR; PG8_WAIT_L(0); PG8_MMA(0, 0, At, B0); PG8_BAR; PG8_SCHED;
            PG8_LDB(B1, 0, 1); PG8_STAGE(PG8_SB(0, 0), b2, voffB);
            PG8_BAR; PG8_WAIT_L(0); PG8_MMA(0, 1, At, B1); PG8_BAR;
            PG8_LDA(At, 0, 1); PG8_STAGE(PG8_SA(0, 0), a2, voffA);
            PG8_BAR; PG8_WAIT_L(0); PG8_MMA(1, 0, At, B0); PG8_BAR; PG8_SCHED;
            PG8_STAGE(PG8_SB(0, 1), b2 + hstep, voffB);
            PG8_WAIT_V(6); PG8_BAR; PG8_MMA(1, 1, At, B1); PG8_BAR;
            PG8_LDB(B0, 1, 0); PG8_SCHED; PG8_LDA(At, 1, 0); PG8_STAGE(PG8_SA(0, 1), a2 + hstep, voffA);
            PG8_WAIT_L(8); PG8_BAR; PG8_WAIT_L(0); PG8_MMA(0, 0, At, B0); PG8_BAR; PG8_SCHED;
            PG8_LDB(B1, 1, 1); PG8_STAGE(PG8_SB(1, 0), b3, voffB);
            PG8_BAR; PG8_WAIT_L(0); PG8_MMA(0, 1, At, B1); PG8_BAR;
            PG8_LDA(At, 1, 1); PG8_STAGE(PG8_SA(1, 0), a3, voffA);
            PG8_BAR; PG8_WAIT_L(0); PG8_MMA(1, 0, At, B0); PG8_BAR; PG8_SCHED;
            PG8_STAGE(PG8_SB(1, 1), b3 + hstep, voffB);
            PG8_WAIT_V(6); PG8_BAR; PG8_MMA(1, 1, At, B1); PG8_BAR;
            }
        }
        if constexpr (ALIGN_EPI) { if (wr == 0) PG8_BAR; }
        if constexpr (!Epi::AFTER_DRAIN) { E(acc, cur, wr, wc, fr, fq); S.done(cur); }
        if (!has_next) break;
#pragma unroll
        for (int a = 0; a < 2; ++a)
#pragma unroll
            for (int b = 0; b < 2; ++b)
#pragma unroll
                for (int m = 0; m < 4; ++m)
#pragma unroll
                    for (int n = 0; n < 2; ++n) acc[a][b][m][n] = (f32x4){0.f, 0.f, 0.f, 0.f};
        cur = nxt; cA = nA; cB = nB; ++ui;
        if constexpr (ALIGN_EPI) { if (wr == 1) PG8_BAR; }
    }
    PG8_WAIT_V(0);
    if constexpr (!ALIGN_EPI) { if (wr == 0) PG8_BAR; }
    PG8_BAR;
    if constexpr (Epi::AFTER_DRAIN) { E.fused(acc, cur, wr, wc, fr, fq, lds, wid, lane); S.done(cur); }
#undef PG8_SA
#undef PG8_SB
#undef PG8_STAGE
#undef PG8_LDA
#undef PG8_LDB
#undef PG8_MMA
#undef PG8_WAIT_V
#undef PG8_WAIT_L
#undef PG8_BAR
#undef PG8_SCHED
}
}

#define LAS __attribute__((address_space(3)))
typedef unsigned short bf16_t;
typedef short bf16x8 __attribute__((ext_vector_type(8)));
typedef short s16x4 __attribute__((ext_vector_type(4)));
typedef float f32x4 __attribute__((ext_vector_type(4)));
typedef float f32x16 __attribute__((ext_vector_type(16)));
typedef unsigned u32x4 __attribute__((ext_vector_type(4)));
typedef unsigned u32x2 __attribute__((ext_vector_type(2)));
constexpr int NWAVES = 8, NTHREADS = 512;
constexpr int LDS_BYTES = 147456;

__device__ __forceinline__ unsigned pk_bf16(float lo, float hi) { return pg8::cvt_pk_bf16(lo, hi); }

__constant__ double INV_FREQ[32] = {1.0, 0.7498942093324559, 0.5623413251903491, 0.4216965034285822, 0.31622776601683794, 0.23713737056616552, 0.1778279410038923, 0.1333521432163324, 0.1,
    0.07498942093324558, 0.05623413251903491, 0.042169650342858224, 0.03162277660168379, 0.023713737056616554, 0.01778279410038923, 0.01333521432163324, 0.01, 0.007498942093324558,
    0.005623413251903491, 0.004216965034285823, 0.0031622776601683794, 0.0023713737056616554, 0.0017782794100389228, 0.001333521432163324, 0.001, 0.0007498942093324559,
    0.0005623413251903491, 0.00042169650342858224, 0.00031622776601683794, 0.00023713737056616554, 0.00017782794100389227, 0.0001333521432163324};

__device__ __forceinline__ void wconv_item(const float* src, const float* src2, int K, int Nsrc, bf16_t* dst, int Ndst, int mode, const float* gain, LAS float* scr, int item, int lane) {
    const int nblk = Ndst / 32, kb = item / nblk, nb = item % nblk, k0 = 64 * kb, n0 = 32 * nb;
    const int np = n0 + (lane & 31);
    const float* s = src; int col = np;
    if (mode == 1) { col = (np >> 5) * 16 + (np & 15); if ((np >> 4) & 1) s = src2; }
    else if (mode == 2) { const int pn = np >> 8, bj = (np >> 7) & 1, wc = (np >> 5) & 3, j = np & 31; col = (4 * pn + wc) * 64 + 32 * bj + j; }
    float wv[32];
#pragma unroll
    for (int i = 0; i < 32; ++i) { const int kk = 2 * i + (lane >> 5); wv[i] = s[(size_t)(k0 + kk) * Nsrc + col]; }
    if (gain) {
#pragma unroll
        for (int i = 0; i < 32; ++i) { const int kk = 2 * i + (lane >> 5); wv[i] *= gain[k0 + kk]; }
    }
#pragma unroll
    for (int i = 0; i < 32; ++i) { const int kk = 2 * i + (lane >> 5); scr[kk * 33 + (lane & 31)] = wv[i]; }
    asm volatile("s_waitcnt lgkmcnt(0)" ::: "memory");
    const int c = lane & 7;
#pragma unroll
    for (int j = 0; j < 4; ++j) { const int n = (lane >> 3) + 8 * j; const LAS float* t = scr + (8 * c) * 33 + n;
        u32x4 o; o.x = pk_bf16(t[0 * 33], t[1 * 33]); o.y = pk_bf16(t[2 * 33], t[3 * 33]); o.z = pk_bf16(t[4 * 33], t[5 * 33]); o.w = pk_bf16(t[6 * 33], t[7 * 33]);
        *(u32x4*)(dst + (size_t)(n0 + n) * K + k0 + 8 * c) = o; }
    asm volatile("s_waitcnt lgkmcnt(0)" ::: "memory");
}

__device__ __forceinline__ void prep_weights(const Params& p, LAS unsigned char* lds, int gw, int NGW, int wave, int lane) {
    LAS float* scr = (LAS float*)(lds + wave * 8704);
    unsigned char* ws = p.ws;
    for (int id = 0; id < 21; ++id) {
        const float* src; const float* src2 = nullptr; int K, Nsrc, Ndst, mode = 0; bf16_t* dst; const float* gain = nullptr;
        if (id < 8) { src = p.pool_w + (size_t)id * 65536; K = 256; Nsrc = 256; Ndst = 256; dst = (bf16_t*)(ws + WS_WPOOL) + (size_t)id * 65536; }
        else if (id < 12) { const int l = id - 8; src = p.w_gate + (size_t)l * DM * FF; src2 = p.w_up + (size_t)l * DM * FF; K = DM; Nsrc = FF; Ndst = 2 * FF; mode = 1;
                            dst = (bf16_t*)(ws + WS_WGU) + (size_t)l * 2 * FF * DM; gain = p.ffn_norm + l * DM; }
        else if (id < 16) { const int l = id - 12; src = p.w_down + (size_t)l * FF * DM; K = FF; Nsrc = DM; Ndst = DM; dst = (bf16_t*)(ws + WS_WDN) + (size_t)l * DM * FF; }
        else if (id == 16) { src = p.w_kv; K = DM; Nsrc = 6144; Ndst = 6144; mode = 2; dst = (bf16_t*)(ws + WS_WKVQ); gain = p.kv_norm; }
        else if (id == 17) { src = p.w_q; K = DM; Nsrc = 3072; Ndst = 3072; mode = 2; dst = (bf16_t*)(ws + WS_WKVQ) + (size_t)6144 * DM; gain = p.b_norm; }
        else if (id == 18) { src = p.w_q + (size_t)DM * 3072; K = DM; Nsrc = 3072; Ndst = 3072; mode = 2; dst = (bf16_t*)(ws + WS_WQ1); gain = p.b_norm + DM; }
        else { const int j = id - 19; src = p.w_o + (size_t)j * DM * DM; K = DM; Nsrc = DM; Ndst = DM; dst = (bf16_t*)(ws + WS_WO) + (size_t)j * DM * DM; }
        const int nitems = (K / 64) * (Ndst / 32);
        for (int it = gw; it < nitems; it += NGW) wconv_item(src, src2, K, Nsrc, dst, Ndst, mode, gain, scr, it, lane);
    }
}

template <int W> __device__ __forceinline__ void pool_rows_prompt(const Params& p, int layer, const float* xp, const LAS float* rst, int t0, int half, int c4, int g, f32x4 gn, bf16_t* Dbuf) {
    const int rfirst = t0 + half * 16, r0 = rfirst - (W - 1), bstart = t0 & ~(SEQ - 1);
    f32x4 u[W + 15];
    const float* xr = xp + (size_t)r0 * DM + c4;
#pragma unroll
    for (int k = 0; k < W + 15; ++k) { const int r = r0 + k; u[k] = (f32x4){0.f, 0.f, 0.f, 0.f}; if (r >= bstart) u[k] = *(const f32x4*)xr; xr += DM; asm volatile("" : "+v"(xr)); }
#pragma unroll
    for (int k = 0; k < W + 15; ++k) { const int r = r0 + k; if (r >= bstart) u[k] = u[k] * rst[r - (t0 - 15)] * gn; }
    f32x4 S = {0.f, 0.f, 0.f, 0.f};
#pragma unroll
    for (int k = 0; k < W - 1; ++k) S += u[k];
#pragma unroll
    for (int i = 0; i < 16; ++i) {
        const int r = rfirst + i; const f32x4 uu = u[W - 1 + i];
        S += uu;
        const int s1 = (r & (SEQ - 1)) + 1; const int cnt = s1 < W ? s1 : W;
        const f32x4 d = S * (1.0f / (float)cnt) - uu;
        u32x2 wv; wv.x = pk_bf16(d[0], d[1]); wv.y = pk_bf16(d[2], d[3]);
        *(u32x2*)(Dbuf + ((size_t)g * MT + r) * 256 + (c4 - 256 * g)) = wv;
        const int s = r & (SEQ - 1), b = r >> 12;
        if (s >= SEQ - 15) *(f32x4*)(p.out + O_PP + ((size_t)(b * 2 + layer) * 15 + (s - (SEQ - 15))) * DM + c4) = uu;
        S -= u[i];
    }
}
template <int W> __device__ __forceinline__ void pool_rows_sample(const Params& p, int layer, const float* xs, const LAS float* rst, int n, int half, int c4, int g, f32x4 gn, bf16_t* Dbuf) {
    const int e0 = 15 + 4 * half - (W - 1);
    const float* sp = p.state_pool + (size_t)(n * 2 + layer) * 15 * DM + c4;
    f32x4 u[W + 3];
#pragma unroll
    for (int k = 0; k < W + 3; ++k) { const int e = e0 + k; u[k] = (e < 15) ? *(const f32x4*)(sp + (size_t)e * DM) : *(const f32x4*)(xs + (size_t)(n * 8 + e - 15) * DM + c4) * rst[e - 15] * gn; }
    f32x4 S = {0.f, 0.f, 0.f, 0.f};
#pragma unroll
    for (int k = 0; k < W - 1; ++k) S += u[k];
    float* po = p.out + O_PS + (size_t)(n * 2 + layer) * 15 * DM + c4;
#pragma unroll
    for (int i = 0; i < 4; ++i) {
        const int t = 4 * half + i, r = MP + n * 8 + t; const f32x4 uu = u[W - 1 + i];
        S += uu;
        const f32x4 d = S * (1.0f / (float)W) - uu;
        u32x2 wv; wv.x = pk_bf16(d[0], d[1]); wv.y = pk_bf16(d[2], d[3]);
        *(u32x2*)(Dbuf + ((size_t)g * MT + r) * 256 + (c4 - 256 * g)) = wv;
        *(f32x4*)(po + (size_t)(7 + t) * DM) = uu;
        S -= u[i];
    }
    if (half == 0) {
#pragma unroll
        for (int k = 0; k < 7; ++k) *(f32x4*)(po + (size_t)k * DM) = *(const f32x4*)(sp + (size_t)(8 + k) * DM);
    }
}
__device__ __forceinline__ float row_ssq3(const float* r0, const float* r1, const float* r2, int lane, float& s1, float& s2) {
    f32x4 v[12];
#pragma unroll
    for (int j = 0; j < 4; ++j) { v[j] = *(const f32x4*)(r0 + 4 * lane + 256 * j); v[4 + j] = *(const f32x4*)(r1 + 4 * lane + 256 * j); v[8 + j] = *(const f32x4*)(r2 + 4 * lane + 256 * j); }
    float a = 0.f, b = 0.f, c = 0.f;
#pragma unroll
    for (int j = 0; j < 4; ++j) { a += (v[j][0] * v[j][0] + v[j][1] * v[j][1]) + (v[j][2] * v[j][2] + v[j][3] * v[j][3]);
        b += (v[4 + j][0] * v[4 + j][0] + v[4 + j][1] * v[4 + j][1]) + (v[4 + j][2] * v[4 + j][2] + v[4 + j][3] * v[4 + j][3]);
        c += (v[8 + j][0] * v[8 + j][0] + v[8 + j][1] * v[8 + j][1]) + (v[8 + j][2] * v[8 + j][2] + v[8 + j][3] * v[8 + j][3]); }
#pragma unroll
    for (int o = 1; o < 64; o <<= 1) { a += __shfl_xor(a, o); b += __shfl_xor(b, o); c += __shfl_xor(c, o); }
    s1 = b; s2 = c; return a;
}
__device__ __forceinline__ void pool_prep(const Params& p, int layer, LAS unsigned char* lds) {
    const int tid = opaque_tid(), lane = tid & 63, wave = tid >> 6;
    LAS float* rst = (LAS float*)(lds + 73728);
    const float* xp = layer == 0 ? p.x_prompt : p.out + O_YP;
    const float* xs = layer == 0 ? p.x_sample : p.out + O_YS;
    const float* gain = p.a_norm + layer * DM;
    bf16_t* Dbuf = (bf16_t*)(p.ws + WS_DBUF);
    const int c4 = (tid & 255) * 4, half = tid >> 8, g = (tid & 255) >> 6;
    const f32x4 gn = *(const f32x4*)(gain + c4);
    const int vblk = (gridDim.x & 7) == 0 ? (int)((blockIdx.x & 7) * (gridDim.x >> 3) + (blockIdx.x >> 3)) : (int)blockIdx.x;
    for (int it = vblk; it < MP / 32; it += gridDim.x) {
        {
            const int t0 = it * 32;
            const bool halo = (t0 & (SEQ - 1)) != 0;
#pragma unroll
            for (int bt = 0; bt < 2; ++bt) {
                int rr[3]; const float* rp[3];
#pragma unroll
                for (int q = 0; q < 3; ++q) { rr[q] = wave + 8 * (3 * bt + q); int r = t0 - 15 + rr[q]; const bool ok = rr[q] < 47 && (rr[q] >= 15 || halo); if (!ok) r = t0; rp[q] = xp + (size_t)r * DM; }
                float s1, s2; const float s0 = row_ssq3(rp[0], rp[1], rp[2], lane, s1, s2);
                if (lane == 0) { if (rr[0] < 47) rst[rr[0]] = 1.0f / sqrtf(s0 * (1.0f / DM) + EPS); if (rr[1] < 47) rst[rr[1]] = 1.0f / sqrtf(s1 * (1.0f / DM) + EPS); if (rr[2] < 47) rst[rr[2]] = 1.0f / sqrtf(s2 * (1.0f / DM) + EPS); }
            }
            __syncthreads();
            if (g == 0) pool_rows_prompt<2>(p, layer, xp, rst, t0, half, c4, g, gn, Dbuf);
            else if (g == 1) pool_rows_prompt<4>(p, layer, xp, rst, t0, half, c4, g, gn, Dbuf);
            else if (g == 2) pool_rows_prompt<8>(p, layer, xp, rst, t0, half, c4, g, gn, Dbuf);
            else pool_rows_prompt<16>(p, layer, xp, rst, t0, half, c4, g, gn, Dbuf);
        }
        __syncthreads();
    }
    for (int it = gridDim.x - 1 - blockIdx.x; it < 32; it += gridDim.x) {
        {
            const int n = it;
            { const float* row = xs + (size_t)(n * 8 + wave) * DM; float ss = 0.f;
#pragma unroll
              for (int j = 0; j < 4; ++j) { const f32x4 v = *(const f32x4*)(row + 4 * lane + 256 * j); ss += (v[0] * v[0] + v[1] * v[1]) + (v[2] * v[2] + v[3] * v[3]); }
#pragma unroll
              for (int o = 1; o < 64; o <<= 1) ss += __shfl_xor(ss, o);
              if (lane == 0) rst[wave] = 1.0f / sqrtf(ss * (1.0f / DM) + EPS); }
            __syncthreads();
            if (g == 0) pool_rows_sample<2>(p, layer, xs, rst, n, half, c4, g, gn, Dbuf);
            else if (g == 1) pool_rows_sample<4>(p, layer, xs, rst, n, half, c4, g, gn, Dbuf);
            else if (g == 2) pool_rows_sample<8>(p, layer, xs, rst, n, half, c4, g, gn, Dbuf);
            else pool_rows_sample<16>(p, layer, xs, rst, n, half, c4, g, gn, Dbuf);
        }
        __syncthreads();
    }
}

__device__ __forceinline__ void phase_prep(const Params& p, LAS unsigned char* lds) {
    const int tid = opaque_tid(), lane = tid & 63, wave = tid >> 6;
    const int gw = blockIdx.x * NWAVES + wave, NGW = gridDim.x * NWAVES;
    const size_t gt = (size_t)blockIdx.x * NTHREADS + tid, NGT = (size_t)gridDim.x * NTHREADS;
    prep_weights(p, lds, gw, NGW, wave, lane);
    { float* ssq = (float*)(p.ws + WS_SSQ); for (size_t i = gt; i < (size_t)8 * MT; i += NGT) ssq[i] = 0.f; }
    { float* rc = (float*)(p.ws + WS_ROPE); float* rs = rc + 4104 * 32;
      for (size_t i = gt; i < (size_t)4104 * 32; i += NGT) { const int pi = (int)(i >> 5), f = (int)(i & 31); const int pos = pi < SEQ ? pi : 8192 + (pi - SEQ);
          const double turns = (double)pos * INV_FREQ[f] * 0.15915494309189535; const double fr = turns - floor(turns);
          const float a = (float)(fr * 6.283185307179586); rc[i] = __builtin_amdgcn_cosf((float)fr); rs[i] = __builtin_amdgcn_sinf((float)fr); } }
    pool_prep(p, 0, lds);
}

__device__ __forceinline__ void phase_merge(const Params& p, int blk, int nblk) {
    const bf16_t* OG = (const bf16_t*)(p.ws + WS_OG); const float* LSE = (const float*)(p.ws + WS_LSE); bf16_t* OB = (bf16_t*)(p.ws + WS_OB);
    const size_t gt = (size_t)blk * NTHREADS + opaque_tid(), NGT = (size_t)nblk * NTHREADS;
    for (size_t i = gt; i < (size_t)MP * 128; i += NGT) {
        const size_t row = i >> 7; const int ch = (int)(i & 127), h = ch >> 3;
        const float l0 = LSE[(0 * (size_t)MP + row) * 16 + h], l1 = LSE[(1 * (size_t)MP + row) * 16 + h], l2 = LSE[(2 * (size_t)MP + row) * 16 + h];
        const float mx = fmaxf(l0, fmaxf(l1, l2));
        float w0 = __builtin_amdgcn_exp2f(l0 - mx), w1 = __builtin_amdgcn_exp2f(l1 - mx), w2 = __builtin_amdgcn_exp2f(l2 - mx);
        const float inv = 1.0f / (w0 + w1 + w2); w0 *= inv; w1 *= inv; w2 *= inv;
        const u32x4 a = *(const u32x4*)(OG + (0 * (size_t)MP + row) * DM + ch * 8), b = *(const u32x4*)(OG + (1 * (size_t)MP + row) * DM + ch * 8), c = *(const u32x4*)(OG + (2 * (size_t)MP + row) * DM + ch * 8);
        u32x4 o;
#pragma unroll
        for (int e = 0; e < 4; ++e) {
            const float lo = w0 * __uint_as_float(a[e] << 16) + w1 * __uint_as_float(b[e] << 16) + w2 * __uint_as_float(c[e] << 16);
            const float hi = w0 * __uint_as_float(a[e] & 0xffff0000u) + w1 * __uint_as_float(b[e] & 0xffff0000u) + w2 * __uint_as_float(c[e] & 0xffff0000u);
            o[e] = pk_bf16(lo, hi);
        }
        *(u32x4*)(OB + row * DM + ch * 8) = o;
    }
}

struct AttnGeom { int dil, r, c, rL; size_t base, lbase, hbase; };
__device__ __forceinline__ AttnGeom attn_geom(int u) {
    const int j5 = (u >> 3) & 31, rc = j5 & 15, h = 2 * (u & 7) + (j5 >> 4), b = (u >> 8) & 3, g = u >> 10;
    AttnGeom G; G.dil = 1 << (2 * g); G.r = rc & (G.dil - 1); G.c = rc >> (2 * g); G.rL = G.r << (12 - 2 * g);
    G.base = ((size_t)g * MP + (size_t)b * SEQ) * DM + h * 64; G.lbase = ((size_t)g * MP + (size_t)b * SEQ) * 16 + h;
    G.hbase = (size_t)((g * 4 + b) * 16 + h) * SEQ * 64; return G;
}
__device__ __forceinline__ void attn_load(const Params& p, int u, int tid, u32x4 (&kreg)[6], u32x4 (&vreg)[6]) {
    const AttnGeom G = attn_geom(u);
    const bf16_t* Kg = (const bf16_t*)(p.ws + WS_KB) + G.hbase; const bf16_t* Vg = (const bf16_t*)(p.ws + WS_VB) + G.hbase;
    const int ch = tid & 7;
#pragma unroll
    for (int k = 0; k < 6; ++k) {
        const int i = (tid >> 3) + 64 * k, kl = 256 * G.c - 128 + i;
        u32x4 kv = {0u, 0u, 0u, 0u}, vv = {0u, 0u, 0u, 0u};
        if (kl >= 0) { const size_t ro = (size_t)(G.rL + kl) * 64 + ch * 8; kv = *(const u32x4*)(Kg + ro); vv = *(const u32x4*)(Vg + ro); }
        kreg[k] = kv; vreg[k] = vv;
    }
}
__device__ __forceinline__ void attn_load_q(const Params& p, int u, int tid, bf16x8 (&qf)[4]) {
    const AttnGeom G = attn_geom(u);
    const bf16_t* Qg = (const bf16_t*)(p.ws + WS_QB) + G.hbase;
    const int lane = tid & 63, wave = tid >> 6, qi = lane & 31, hi = lane >> 5;
    const size_t qro = (size_t)(G.rL + 256 * G.c + 32 * wave + qi) * 64;
#pragma unroll
    for (int d0 = 0; d0 < 4; ++d0) qf[d0] = *(const bf16x8*)(Qg + qro + d0 * 16 + hi * 8);
}
__device__ __forceinline__ void attn_stage(int tid, LAS unsigned char* lds, const u32x4 (&kreg)[6], const u32x4 (&vreg)[6]) {
    const int ch = tid & 7;
#pragma unroll
    for (int k = 0; k < 6; ++k) {
        const int i = (tid >> 3) + 64 * k;
        *(LAS u32x4*)(lds + i * 128 + ((ch ^ ((i >> 1) & 7)) << 4)) = kreg[k];
        *(LAS u32x4*)(lds + 49152 + i * 128 + ((ch ^ (((i >> 1) & 1) << 2)) << 4)) = vreg[k];
    }
}
__device__ __forceinline__ int crow(int r, int hi) { return (r & 3) + 8 * (r >> 2) + 4 * hi; }
__device__ __forceinline__ void attn_compute(const Params& p, int u, int tid, LAS unsigned char* lds, const bf16x8 (&qf)[4]) {
    const int lane = tid & 63, wave = __builtin_amdgcn_readfirstlane(tid >> 6);
    const AttnGeom G = attn_geom(u);
    const int c = G.c;
    bf16_t* Og = (bf16_t*)(p.ws + WS_OG) + G.base; float* Lg = (float*)(p.ws + WS_LSE) + G.lbase;
    LAS unsigned char* ldsK = lds; LAS unsigned char* ldsV = lds + 49152;
    const int qi = lane & 31, hi = lane >> 5;
    const size_t posq = (size_t)(G.r + G.dil * (256 * c + 32 * wave + qi));
    f32x16 o0, o1;
#pragma unroll
    for (int e = 0; e < 16; ++e) { o0[e] = 0.f; o1[e] = 0.f; }
    float mrun = -1e30f, lrun = 0.f;
    const int jstart = (c == 0 && wave < 4) ? 4 - wave : 0;
    for (int jt = jstart; jt < 5; ++jt) {
        const int rowb = 32 * (wave + jt), krow = rowb + qi;
        f32x16 s;
#pragma unroll
        for (int e = 0; e < 16; ++e) s[e] = 0.f;
#pragma unroll
        for (int d0 = 0; d0 < 4; ++d0) { const int ch = 2 * d0 + hi;
            const bf16x8 kf = *(const LAS bf16x8*)(ldsK + krow * 128 + ((ch ^ ((krow >> 1) & 7)) << 4));
            s = __builtin_amdgcn_mfma_f32_32x32x16_bf16(kf, qf[d0], s, 0, 0, 0); }
        if (jt == 0) {
#pragma unroll
            for (int e = 0; e < 16; ++e) if (crow(e, hi) < qi) s[e] = -1e30f;
        }
        if (jt == 4) {
#pragma unroll
            for (int e = 0; e < 16; ++e) if (crow(e, hi) > qi) s[e] = -1e30f;
        }
        float mx = s[0];
#pragma unroll
        for (int e = 1; e < 16; ++e) mx = fmaxf(mx, s[e]);
        mx = fmaxf(mx, __shfl_xor(mx, 32));
        const float mnew = fmaxf(mrun, mx), alpha = __builtin_amdgcn_exp2f(mrun - mnew);
        float ls = 0.f;
#pragma unroll
        for (int e = 0; e < 16; ++e) { s[e] = __builtin_amdgcn_exp2f(s[e] - mnew); ls += s[e]; }
        lrun = lrun * alpha + ls; mrun = mnew;
#pragma unroll
        for (int e = 0; e < 16; ++e) { o0[e] *= alpha; o1[e] *= alpha; }
#pragma unroll
        for (int ks = 0; ks < 2; ++ks) {
            u32x4 pw; pw.x = pk_bf16(s[8 * ks + 0], s[8 * ks + 1]); pw.y = pk_bf16(s[8 * ks + 2], s[8 * ks + 3]); pw.z = pk_bf16(s[8 * ks + 4], s[8 * ks + 5]); pw.w = pk_bf16(s[8 * ks + 6], s[8 * ks + 7]);
            const bf16x8 pf = __builtin_bit_cast(bf16x8, pw);
            const int vrow = rowb + 16 * ks + 4 * hi + ((lane & 15) >> 2);
#pragma unroll
            for (int d0 = 0; d0 < 2; ++d0) {
                const int chv = 4 * d0 + 2 * ((lane >> 4) & 1) + ((lane & 3) >> 1);
                LAS unsigned char* a1 = ldsV + vrow * 128 + ((chv ^ (((vrow >> 1) & 1) << 2)) << 4) + 8 * (lane & 1);
                const s16x4 lo = __builtin_bit_cast(s16x4, __builtin_amdgcn_ds_read_tr16_b64_v4i16((LAS s16x4*)a1));
                const s16x4 hi4 = __builtin_bit_cast(s16x4, __builtin_amdgcn_ds_read_tr16_b64_v4i16((LAS s16x4*)(a1 + 8 * 128)));
                const bf16x8 vf = {lo[0], lo[1], lo[2], lo[3], hi4[0], hi4[1], hi4[2], hi4[3]};
                if (d0 == 0) o0 = __builtin_amdgcn_mfma_f32_32x32x16_bf16(vf, pf, o0, 0, 0, 0);
                else o1 = __builtin_amdgcn_mfma_f32_32x32x16_bf16(vf, pf, o1, 0, 0, 0);
            }
        }
    }
    lrun += __shfl_xor(lrun, 32);
    const float inv = 1.0f / lrun;
    LAS unsigned char* stg = lds + 98304 + wave * 4096;
#pragma unroll
    for (int a = 0; a < 4; ++a) {
        u32x2 w0, w1;
        w0.x = pk_bf16(o0[4 * a] * inv, o0[4 * a + 1] * inv); w0.y = pk_bf16(o0[4 * a + 2] * inv, o0[4 * a + 3] * inv);
        w1.x = pk_bf16(o1[4 * a] * inv, o1[4 * a + 1] * inv); w1.y = pk_bf16(o1[4 * a + 2] * inv, o1[4 * a + 3] * inv);
        *(LAS u32x2*)(stg + qi * 128 + (((a) ^ (qi & 7)) << 4) + 8 * hi) = w0;
        *(LAS u32x2*)(stg + qi * 128 + (((4 + a) ^ (qi & 7)) << 4) + 8 * hi) = w1;
    }
    asm volatile("s_waitcnt lgkmcnt(0)" ::: "memory");
#pragma unroll
    for (int i = 0; i < 4; ++i) {
        const int row = i * 8 + (lane >> 3), ch = lane & 7;
        const u32x4 v = *(const LAS u32x4*)(stg + row * 128 + ((ch ^ (row & 7)) << 4));
        const size_t pr = (size_t)(G.r + G.dil * (256 * c + 32 * wave + row));
        *(u32x4*)(Og + pr * DM + ch * 8) = v;
    }
    if (hi == 0) Lg[posq * 16] = mrun + __builtin_amdgcn_logf(lrun);
}

__device__ __forceinline__ f32x4 bf4_to_f32(u32x2 w) { f32x4 r; r[0] = __uint_as_float(w.x << 16); r[1] = __uint_as_float(w.x & 0xffff0000u); r[2] = __uint_as_float(w.y << 16); r[3] = __uint_as_float(w.y & 0xffff0000u); return r; }
struct SampState { float m, l; f32x4 o; };
__device__ __forceinline__ void sample_load(const Params& p, int u, int bi, int tid, u32x2 (&kk)[11], u32x2 (&vv)[11], f32x4& q4) {
    const int lane = tid & 63, t = tid >> 6, n = u >> 4, h = u & 15, kq = lane >> 4, dq = lane & 15, g = bi / 3, ci = bi - 3 * g;
    const int hist = 128 << (2 * g), dil = 1 << (2 * g);
    const bf16_t* CK = (const bf16_t*)(p.ws + WS_CK); const bf16_t* CV = (const bf16_t*)(p.ws + WS_CV);
    const size_t cb = pg8::ckv_off(g, n, h, 0) + 4 * dq;
    q4 = *(const f32x4*)((const float*)(p.ws + WS_QS) + (size_t)(n * 8 + t) * 3072 + (g * 16 + h) * 64 + 4 * dq);
#pragma unroll
    for (int i = 0; i < 11; ++i) {
        const int j = 4 * (11 * ci + i) + kq, jc = j <= 128 ? j : 128;
        const int idxc = g == 2 ? (128 - jc) * 8 + t : hist + t - dil * jc;
        kk[i] = *(const u32x2*)(CK + cb + (size_t)idxc * 64); vv[i] = *(const u32x2*)(CV + cb + (size_t)idxc * 64);
    }
}
__device__ __forceinline__ void sample_math(int bi, int tid, const u32x2 (&kk)[11], const u32x2 (&vv)[11], const f32x4 q4, SampState& S) {
    const int kq = (tid & 63) >> 4, ci = bi % 3;
    float m = S.m, l = S.l; f32x4 o = S.o;
#pragma unroll
    for (int i = 0; i < 11; ++i) {
        const int j = 4 * (11 * ci + i) + kq;
        const f32x4 k4 = bf4_to_f32(kk[i]), v4 = bf4_to_f32(vv[i]);
        float s = (q4[0] * k4[0] + q4[1] * k4[1]) + (q4[2] * k4[2] + q4[3] * k4[3]);
        s += __shfl_xor(s, 1); s += __shfl_xor(s, 2); s += __shfl_xor(s, 4); s += __shfl_xor(s, 8);
        if (j > 128) s = -1e30f;
        const float mnew = fmaxf(m, s), alpha = __builtin_amdgcn_exp2f(m - mnew), pp = __builtin_amdgcn_exp2f(s - mnew);
        l = l * alpha + pp; o = o * alpha + v4 * pp; m = mnew;
    }
    S.m = m; S.l = l; S.o = o;
}
__device__ __forceinline__ void sample_finish(const Params& p, int u, int tid, SampState& S) {
    const int lane = tid & 63, t = tid >> 6, n = u >> 4, h = u & 15, kq = lane >> 4, dq = lane & 15;
    float m = S.m, l = S.l; f32x4 o = S.o;
    float M = fmaxf(m, __shfl_xor(m, 16)); M = fmaxf(M, __shfl_xor(M, 32));
    const float f = __builtin_amdgcn_exp2f(m - M); l *= f; o = o * f;
    l += __shfl_xor(l, 16); l += __shfl_xor(l, 32);
#pragma unroll
    for (int e = 0; e < 4; ++e) { float x = o[e]; x += __shfl_xor(x, 16); x += __shfl_xor(x, 32); o[e] = x; }
    if (kq == 0) { const float inv = 1.0f / l; u32x2 w; w.x = pk_bf16(o[0] * inv, o[1] * inv); w.y = pk_bf16(o[2] * inv, o[3] * inv);
        *(u32x2*)((bf16_t*)(p.ws + WS_OB) + (size_t)(MP + n * 8 + t) * DM + h * 64 + 4 * dq) = w; }
    S.m = -1e30f; S.l = 0.f; S.o = (f32x4){0.f, 0.f, 0.f, 0.f};
}
__device__ __forceinline__ void phase_attn(const Params& p, LAS unsigned char* lds, int dup) {
    const int tid = opaque_tid();
    int su = blockIdx.x, sb = 0;
    SampState S; S.m = -1e30f; S.l = 0.f; S.o = (f32x4){0.f, 0.f, 0.f, 0.f};
    int u = blockIdx.x;
    u32x4 kreg[6], vreg[6]; bf16x8 qf[4];
    if (u < 3072) { attn_load(p, u, tid, kreg, vreg); attn_load_q(p, u, tid, qf); }
    for (; u < 3072; u += gridDim.x) {
        attn_stage(tid, lds, kreg, vreg);
        __syncthreads();
        const bool hs = su < 512;
        u32x2 kk[11], vv[11]; f32x4 q4;
        if (hs) sample_load(p, su, sb, tid, kk, vv, q4);
        const int un = u + gridDim.x;
        if (un < 3072) attn_load(p, un, tid, kreg, vreg);
        attn_compute(p, u, tid, lds, qf);
        if (un < 3072) attn_load_q(p, un, tid, qf);
        if (hs) { sample_math(sb, tid, kk, vv, q4, S); if (++sb == 9) { sample_finish(p, su, tid, S); sb = 0; su += gridDim.x; } }
        __syncthreads();
    }
    if (su < 512) {
        u32x2 ka[11], va[11], kb[11], vb[11]; f32x4 qa, qb;
        sample_load(p, su, sb, tid, ka, va, qa);
        for (;;) {
            int su2 = su, sb2 = sb + 1; if (sb2 == 9) { sb2 = 0; su2 += gridDim.x; }
            const bool more = su2 < 512;
            if (more) sample_load(p, su2, sb2, tid, kb, vb, qb);
            sample_math(sb, tid, ka, va, qa, S); if (sb == 8) sample_finish(p, su, tid, S);
            if (!more) break;
            su = su2; sb = sb2;
            su2 = su; sb2 = sb + 1; if (sb2 == 9) { sb2 = 0; su2 += gridDim.x; }
            const bool more2 = su2 < 512;
            if (more2) sample_load(p, su2, sb2, tid, ka, va, qa);
            sample_math(sb, tid, kb, vb, qb, S); if (sb == 8) sample_finish(p, su, tid, S);
            if (!more2) break;
            su = su2; sb = sb2;
        }
    }
}

constexpr int NTASK_A = 32 * (16 + 64 + 128), NTASK = NTASK_A + 32 * 128;
struct ChunkGeom { int g, n, R0, hist; };
__device__ __forceinline__ ChunkGeom chunk_geom(int it) {
    ChunkGeom C; int ck;
    if (it < 32 * 16) { C.g = 0; C.n = it >> 4; ck = it & 15; }
    else if (it < 32 * (16 + 64)) { const int r = it - 32 * 16; C.g = 1; C.n = r >> 6; ck = r & 63; }
    else if (it < NTASK_A) { const int r = it - 32 * (16 + 64); C.g = 2; C.n = r >> 7; ck = 2 * (r & 127); }
    else { const int r = it - NTASK_A; C.g = 2; C.n = r >> 7; ck = 2 * (r & 127) + 1; }
    C.hist = 128 << (2 * C.g); C.R0 = 8 * ck; return C;
}
__device__ __forceinline__ void chunk_load(const Params& p, int it, int tid, f32x4 (&v)[8]) {
    const ChunkGeom C = chunk_geom(it);
    const float* cache = C.g == 0 ? p.cache0 : (C.g == 1 ? p.cache1 : p.cache2);
    const f32x4* src = (const f32x4*)(cache + ((size_t)C.n * C.hist + C.R0) * 2048) + tid;
#pragma unroll
    for (int k = 0; k < 8; ++k) v[k] = __builtin_nontemporal_load(src + k * 512);
}
__device__ __forceinline__ void chunk_store(const Params& p, int it, int tid, const f32x4 (&v)[8]) {
    const ChunkGeom C = chunk_geom(it);
    if (C.R0 >= 8) {
        f32x4* dst = (f32x4*)(p.out + (C.g == 0 ? O_KS0 : (C.g == 1 ? O_KS1 : O_KS2)) + ((size_t)C.n * C.hist + C.R0 - 8) * 2048) + tid;
#pragma unroll
        for (int k = 0; k < 8; ++k) __builtin_nontemporal_store(v[k], dst + k * 512);
    }
    if (it < NTASK_A) {
        const int kv = tid >> 8, h = (tid >> 4) & 15, d4 = tid & 15;
        const int idxc0 = C.g == 2 ? (C.R0 >> 4) * 8 : C.R0;
        bf16_t* cp = (bf16_t*)(p.ws + (kv ? WS_CV : WS_CK)) + pg8::ckv_off(C.g, C.n, h, idxc0) + 4 * d4;
#pragma unroll
        for (int k = 0; k < 8; ++k) { u32x2 w; w.x = pk_bf16(v[k][0], v[k][1]); w.y = pk_bf16(v[k][2], v[k][3]); *(u32x2*)(cp + k * 64) = w; }
    }
}
__device__ __forceinline__ void steal_work(const Params& p, LAS unsigned char* lds, int k, unsigned mand) {
    unsigned* ctl = (unsigned*)(p.ws + WS_CTL);
    const int tid = opaque_tid();
    LAS int* flag = (LAS int*)lds;
    __syncthreads();
    if (k >= 0 && tid == 0) atomicAdd(ctl + 64 + 16 * k, 1u);
    for (;;) {
        if (tid == 0) {
            int t0 = -1, t1 = -1; bool go = true, forced = k < 0;
            if (k >= 0) go = __hip_atomic_load(ctl + 64 + 16 * k, __ATOMIC_RELAXED, __HIP_MEMORY_SCOPE_AGENT) < gridDim.x;
            if (!go && mand) { go = __hip_atomic_load(ctl, __ATOMIC_RELAXED, __HIP_MEMORY_SCOPE_AGENT) < mand; forced = go; }
            if (go) { const unsigned nt = forced ? 2u : 1u; const unsigned tk = atomicAdd(ctl, nt); if (tk < (unsigned)NTASK) t0 = (int)tk; if (nt == 2u && tk + 1u < (unsigned)NTASK) t1 = (int)(tk + 1u); }
            flag[0] = t0; flag[1] = t1;
        }
        __syncthreads();
        const int t0 = flag[0], t1 = flag[1];
        __syncthreads();
        if (t0 < 0) break;
        f32x4 va[8];
        chunk_load(p, t0, tid, va);
        if (t1 >= 0) { f32x4 vb[8]; chunk_load(p, t1, tid, vb); chunk_store(p, t0, tid, va); chunk_store(p, t1, tid, vb); }
        else chunk_store(p, t0, tid, va);
    }
}

#define XB_TMO      128
#define XB_XCNT(j)  (256  + 64 * (j))
#define XB_XSUB(j)  (1280 + 64 * (j))
#define XB_XGEN(j)  (2304 + 64 * (j))
#define XB_TOP      3328
#define XB_TOPGEN   3392
#define XCD_BAR_WORDS 3456
#define XB_SPIN_CAP (1u << 18)

__device__ __forceinline__ unsigned xb_ld(unsigned* p)              { return __hip_atomic_load(p, __ATOMIC_RELAXED, __HIP_MEMORY_SCOPE_AGENT); }
__device__ __forceinline__ unsigned xb_add(unsigned* p, unsigned v) { return __hip_atomic_fetch_add(p, v, __ATOMIC_RELAXED, __HIP_MEMORY_SCOPE_AGENT); }
__device__ __forceinline__ unsigned xb_xcc_id() { return (unsigned)__builtin_amdgcn_s_getreg((3 << 11) | 20) & 0xFu; }
#define XB_SPIN(cond, bar) do { unsigned _sp = 0; while (cond) { __builtin_amdgcn_s_sleep(1); \
    if ((++_sp & 255u) == 0u) { if (xb_ld(&(bar)[XB_TMO])) break; if (_sp > XB_SPIN_CAP) { atomicAdd(&(bar)[XB_TMO], 1u); break; } } } } while (0)

struct XcdBarrier {
    unsigned* bar; unsigned x;
    volatile LAS unsigned* st;
};

__device__ __forceinline__ XcdBarrier xcd_barrier_post(unsigned* bar, volatile LAS unsigned* st) {
    XcdBarrier b; b.bar = bar; b.x = xb_xcc_id(); b.st = st;
    if (threadIdx.x == 0) (void)xb_add(&bar[XB_XCNT(b.x)], 1u);
    return b;
}
__device__ __forceinline__ void xcd_barrier_complete(unsigned* bar, unsigned x, unsigned& nloc, unsigned& nx) {
    const unsigned G = gridDim.x * gridDim.y * gridDim.z;
    unsigned sum, cnt, mine, sp = 0u;
    for (;;) {
        sum = 0u; cnt = 0u; mine = 0u;
#pragma unroll
        for (unsigned j = 0; j < 16; ++j) { const unsigned c = xb_ld(&bar[XB_XCNT(j)]); sum += c; cnt += (c > 0u) ? 1u : 0u; mine = (j == x) ? c : mine; }
        if (sum == G) break;
        __builtin_amdgcn_s_sleep(1);
        if ((++sp & 255u) == 0u) { if (xb_ld(&bar[XB_TMO])) break; if (sp > XB_SPIN_CAP) { atomicAdd(&bar[XB_TMO], 1u); break; } }
    }
    nloc = mine > 0u ? mine : 1u; nx = cnt > 0u ? cnt : 1u;
}

__device__ __forceinline__ void xcd_barrier(const XcdBarrier& b) {
    asm volatile("s_waitcnt vmcnt(0)" ::: "memory");
    __syncthreads();
    if (threadIdx.x == 0) {
        unsigned* bar = b.bar;
        __builtin_amdgcn_s_waitcnt(0);
        unsigned nloc = b.st[0], nx = b.st[1];
        if (nloc == 0u) { xcd_barrier_complete(bar, b.x, nloc, nx); b.st[0] = nloc; b.st[1] = nx; }
        const unsigned old = xb_add(&bar[XB_XSUB(b.x)], 1u);
        const unsigned gen = old / nloc;
        if (old + 1u == (gen + 1u) * nloc) {
            __builtin_amdgcn_fence(__ATOMIC_RELEASE, "agent");
            asm volatile("s_waitcnt vmcnt(0)" ::: "memory");
            const unsigned og = xb_add(&bar[XB_TOP], 1u);
            const unsigned tg = og / nx;
            if (og + 1u == (tg + 1u) * nx) xb_add(&bar[XB_TOPGEN], 1u);
            else XB_SPIN(xb_ld(&bar[XB_TOPGEN]) == tg, bar);
            __builtin_amdgcn_fence(__ATOMIC_ACQUIRE, "agent");
            xb_add(&bar[XB_XGEN(b.x)], 1u);
            asm volatile("s_waitcnt vmcnt(0)" ::: "memory");
        } else {
            XB_SPIN(xb_ld(&bar[XB_XGEN(b.x)]) == gen, bar);
            __builtin_amdgcn_fence(__ATOMIC_ACQUIRE, "agent");
            asm volatile("s_waitcnt vmcnt(0)" ::: "memory");
        }
    }
    __syncthreads();
}

__device__ __forceinline__ void seam_barrier(const Params& p, int k) {
    unsigned* w = (unsigned*)(p.ws + WS_CTL) + 3072 + 16 * k;
    __syncthreads();
    if (opaque_tid() == 0) {
        __builtin_amdgcn_fence(__ATOMIC_RELEASE, "agent");
        asm volatile("s_waitcnt vmcnt(0)" ::: "memory");
        __hip_atomic_fetch_add(w, 1u, __ATOMIC_RELAXED, __HIP_MEMORY_SCOPE_AGENT);
        unsigned spins = 0;
        while (__hip_atomic_load(w, __ATOMIC_RELAXED, __HIP_MEMORY_SCOPE_AGENT) < gridDim.x) { __builtin_amdgcn_s_sleep(1); if (++spins > (1u << 24)) break; }
        __builtin_amdgcn_fence(__ATOMIC_ACQUIRE, "agent");
        asm volatile("s_waitcnt vmcnt(0)" ::: "memory");
    }
    __syncthreads();
}

constexpr int NSTEPS = 20;
#ifndef PROBE_DUP_MASK
#define PROBE_DUP_MASK 0u
#endif
__global__ void __launch_bounds__(NTHREADS, 2) yoco_fwd(Params p) {
    extern __shared__ __attribute__((aligned(16))) unsigned char lds_raw[];
    LAS unsigned char* lds = (LAS unsigned char*)lds_raw;
    cg::grid_group grid = cg::this_grid();
    volatile LAS unsigned* xst = (volatile LAS unsigned*)(lds + 131072 + 64);
    if (threadIdx.x == 0) { xst[0] = 0u; xst[1] = 0u; }
    __syncthreads();
    const XcdBarrier xbar = xcd_barrier_post((unsigned*)(p.ws + WS_CTL) + 4096, xst);
    grid.sync();
    unsigned char* ws = p.ws;
    float* X = p.out + O_YP;
    bf16_t* XB = (bf16_t*)(ws + WS_XB); bf16_t* H = (bf16_t*)(ws + WS_H); float* SSQ = (float*)(ws + WS_SSQ);
    const float* ropec = (const float*)(ws + WS_ROPE); const float* ropes = ropec + 4104 * 32;
    const int G = gridDim.x, c = blockIdx.x;
#pragma unroll 1
    for (int st2 = 2 * p.lo; st2 < 2 * p.hi; ++st2) {
        const int st = st2 >> 1;
        if ((st2 & 1) && !((PROBE_DUP_MASK >> st) & 1u)) continue;
        int kind, layer = 0, ssq_in = 0, ssq_out = -1;
        switch (st) {
            case 0: kind = 0; break;
            case 1: kind = 1; layer = 0; ssq_out = 0; break;
            case 2: kind = 2; layer = 0; ssq_in = 0; break;
            case 3: kind = 3; layer = 0; break;
            case 4: kind = 4; break;
            case 5: kind = 1; layer = 1; ssq_out = 1; break;
            case 6: kind = 2; layer = 1; ssq_in = 1; break;
            case 7: kind = 3; layer = 1; ssq_out = 2; break;
            case 8: kind = 5; ssq_in = 2; break;
            case 9: kind = 6; break;
            case 10: kind = 7; break;
            case 11: kind = 8; layer = 0; ssq_out = 3; break;
            case 12: kind = 2; layer = 2; ssq_in = 3; break;
            case 13: kind = 3; layer = 2; ssq_out = 4; break;
            case 14: kind = 9; ssq_in = 4; break;
            case 15: kind = 6; break;
            case 16: kind = 7; break;
            case 17: kind = 8; layer = 1; ssq_out = 5; break;
            case 18: kind = 2; layer = 3; ssq_in = 5; break;
            default: kind = 3; layer = 3; break;
        }
#ifdef PROBE_EMPTY_DUP
        if (st2 & 1) kind = -1;
#endif
        if (kind < 0) {}
        else if (kind == 0) phase_prep(p, lds);
        else if (kind == 4) pool_prep(p, 1, lds);
        else if (kind == 6) phase_attn(p, lds, st2 & 1);
        else if (kind == 7) {
            if (c < G - 4) phase_merge(p, c, G - 4);
            else {
                const int j = st == 10 ? 0 : 1, so = j == 0 ? 3 : 5;
                pg8::Gemm g{(const bf16_t*)(ws + WS_OB), (const bf16_t*)(ws + WS_WO) + (size_t)j * DM * DM, MT, DM, DM};
                pg8::StaticOrder S; S.init(MP, DM, G, c - (G - 4), 4);
                pg8::EpiResid E; E.X = X; E.scale = nullptr; E.xin_p = X; E.xin_s = X + (size_t)MP * DM; E.xb = XB; E.ssq = SSQ + (size_t)so * MT;
                pg8::gemm_phase<pg8::EpiResid, pg8::StaticOrder, true, true>(lds, g, S, E);
            }
        }
        else if (kind == 2) {
            unsigned* scnt = (unsigned*)(ws + WS_CTL) + 2048 + 16 * layer;
            if (c < G - 8) {
                pg8::Gemm g{XB, (const bf16_t*)(ws + WS_WGU) + (size_t)layer * 2 * FF * DM, MT, 2 * FF, DM};
                pg8::StaticOrder S; S.init(MP, 2 * FF, G - 8, c, 3); S.cnt = scnt;
                pg8::EpiGU E{SSQ + (size_t)ssq_in * MT, H};
                pg8::gemm_phase<pg8::EpiGU, pg8::StaticOrder, true, true>(lds, g, S, E);
            } else if (c < G - 4) {
                if (opaque_tid() == 0) { while (__hip_atomic_load(scnt, __ATOMIC_RELAXED, __HIP_MEMORY_SCOPE_AGENT) < 22u) __builtin_amdgcn_s_sleep(32); }
                __syncthreads();
                __builtin_amdgcn_fence(__ATOMIC_ACQUIRE, "agent");
                const int so = layer == 1 ? 2 : (layer == 2 ? 4 : -1);
                pg8::Gemm g{H, (const bf16_t*)(ws + WS_WDN) + (size_t)layer * DM * FF, MT, DM, FF};
                pg8::StaticOrder S; S.init(MP, DM, G, c - (G - 8), 4);
                pg8::EpiResid E; E.X = X; E.scale = nullptr; E.xin_p = X; E.xin_s = X + (size_t)MP * DM;
                E.xb = so >= 0 ? XB : nullptr; E.ssq = so >= 0 ? SSQ + (size_t)so * MT : nullptr;
                pg8::gemm_phase<pg8::EpiResid, pg8::StaticOrder, true, true>(lds, g, S, E);
            }
        } else if (kind == 5 || kind == 9) {
            pg8::Gemm g{XB, (const bf16_t*)(ws + (kind == 5 ? WS_WKVQ : WS_WQ1)), MT, kind == 5 ? 9216 : 3072, DM};
            pg8::StaticOrder S; S.init(MT, g.N, G, c, 0);
            pg8::EpiQKV E{SSQ + (size_t)ssq_in * MT, kind == 5 ? 0 : 24, p.k_norm, p.q_norm + (kind == 5 ? 0 : 192), ropec, ropes,
                          (bf16_t*)(ws + WS_KB), (bf16_t*)(ws + WS_VB), (bf16_t*)(ws + WS_QB), (float*)(ws + WS_QS), p.out, (bf16_t*)(ws + WS_CK), (bf16_t*)(ws + WS_CV)};
            pg8::gemm_phase<pg8::EpiQKV, pg8::StaticOrder, true, true>(lds, g, S, E);
        } else {
            pg8::Gemm g; pg8::StaticOrder S; pg8::EpiResid E;
            E.X = X; E.scale = nullptr; E.xin_p = X; E.xin_s = X + (size_t)MP * DM;
            E.xb = ssq_out >= 0 ? XB : nullptr; E.ssq = ssq_out >= 0 ? SSQ + (size_t)ssq_out * MT : nullptr;
            if (kind == 1) {
                g = pg8::Gemm{(const bf16_t*)(ws + WS_DBUF), (const bf16_t*)(ws + WS_WPOOL) + (size_t)layer * 4 * 65536, 4 * MT, 1024, 256};
                S.init(MT, 1024, G, c, 1); E.scale = p.pool_scale + layer * DM;
                if (layer == 0) { E.xin_p = p.x_prompt; E.xin_s = p.x_sample; }
            } else if (kind == 3) {
                g = pg8::Gemm{H, (const bf16_t*)(ws + WS_WDN) + (size_t)layer * DM * FF, MP, DM, FF};
                S.init(MP, DM, G, c, 0);
            } else {
                g = pg8::Gemm{(const bf16_t*)(ws + WS_OB), (const bf16_t*)(ws + WS_WO) + (size_t)layer * DM * DM, MP, DM, DM};
                S.init(MP, DM, G, c, 0);
            }
            pg8::gemm_phase<pg8::EpiResid, pg8::StaticOrder, true, true>(lds, g, S, E);
        }
        if (st2 + 2 < 2 * p.hi) {
            if (kind == 1 || kind == 2 || kind == 5 || kind == 9) steal_work(p, lds, st2, st == 8 ? (unsigned)NTASK_A : 0u);
            xcd_barrier(xbar);
        }
    }
    steal_work(p, lds, -1, 0u);
}

extern "C" void kernel_launch(void* const* d_in, const int* in_sizes, int n_in, void* d_out, int out_size, void* d_ws, size_t ws_size, hipStream_t stream) {
    static int grid = 0;
    if (grid == 0) {
        if (n_in != 20 || (size_t)out_size != O_END || ws_size < WS_END) { fprintf(stderr, "kernel_launch: unexpected shapes: n_in %d out %d ws %zu (need %zu)\n", n_in, out_size, ws_size, (size_t)WS_END); grid = -1; return; }
        int dev = 0, cus = 0, per_cu = 0;
        hipGetDevice(&dev); hipDeviceGetAttribute(&cus, hipDeviceAttributeMultiprocessorCount, dev);
        if (hipFuncSetAttribute((const void*)yoco_fwd, hipFuncAttributeMaxDynamicSharedMemorySize, LDS_BYTES) != hipSuccess) { fprintf(stderr, "kernel_launch: hipFuncSetAttribute failed\n"); grid = -1; return; }
        if (hipOccupancyMaxActiveBlocksPerMultiprocessor(&per_cu, (const void*)yoco_fwd, NTHREADS, LDS_BYTES) != hipSuccess || per_cu < 1) { fprintf(stderr, "kernel_launch: occupancy query failed (%d)\n", per_cu); (void)hipGetLastError(); per_cu = 1; }
        grid = cus * per_cu;
    }
    if (grid < 0) return;
    Params p{};
    const float** pp = (const float**)&p;
    for (int i = 0; i < 20; ++i) pp[i] = (const float*)d_in[i];
    p.out = (float*)d_out; p.ws = (unsigned char*)d_ws; p.lo = 0; p.hi = NSTEPS;
    if (hipMemsetAsync((unsigned char*)d_ws + WS_CTL, 0, 32768, stream) != hipSuccess) { fprintf(stderr, "kernel_launch: memset failed\n"); return; }
    void* args[] = {&p};
    hipError_t e = hipLaunchCooperativeKernel((const void*)yoco_fwd, dim3(grid), dim3(NTHREADS), args, LDS_BYTES, stream);
    if (e != hipSuccess) fprintf(stderr, "kernel_launch: cooperative launch failed: %s (grid %d)\n", hipGetErrorString(e), grid);
}
```

```cpp
#include <hip/hip_runtime.h>
#include <hip/hip_cooperative_groups.h>
#include <cstdio>
#include <cstdint>
namespace cg = cooperative_groups;

constexpr int MP = 16384, MS = 256, MT = MP + MS, DM = 1024, FF = 2816, SEQ = 4096, NTM = MT / 256;
constexpr float EPS = 1e-6f;
constexpr float C2 = 0.125f * 1.4426950408889634f;
constexpr size_t O_YP = 0, O_YS = O_YP + (size_t)MP * DM, O_PP = O_YS + (size_t)MS * DM, O_PS = O_PP + 4 * 2 * 15 * 1024,
                 O_KP0 = O_PS + 32 * 2 * 15 * 1024, O_KS0 = O_KP0 + (size_t)4 * 128 * 2048, O_KP1 = O_KS0 + (size_t)32 * 128 * 2048,
                 O_KS1 = O_KP1 + (size_t)4 * 512 * 2048, O_KP2 = O_KS1 + (size_t)32 * 512 * 2048, O_KS2 = O_KP2 + (size_t)4 * 2048 * 2048,
                 O_END = O_KS2 + (size_t)32 * 2048 * 2048;
constexpr size_t AL(size_t x) { return (x + 65535) & ~(size_t)65535; }
constexpr size_t WS_WPOOL = 0;
constexpr size_t WS_WGU = AL(WS_WPOOL + (size_t)8 * 65536 * 2);
constexpr size_t WS_WDN = AL(WS_WGU + (size_t)4 * 5632 * 1024 * 2);
constexpr size_t WS_WKVQ = AL(WS_WDN + (size_t)4 * 1024 * 2816 * 2);
constexpr size_t WS_WQ1 = AL(WS_WKVQ + (size_t)9216 * 1024 * 2);
constexpr size_t WS_WO = AL(WS_WQ1 + (size_t)3072 * 1024 * 2);
constexpr size_t WS_DBUF = AL(WS_WO + (size_t)2 * 1024 * 1024 * 2);
constexpr size_t WS_XB = AL(WS_DBUF + (size_t)4 * MT * 256 * 2);
constexpr size_t WS_H = AL(WS_XB + (size_t)MT * 1024 * 2);
constexpr size_t WS_KB = AL(WS_H + (size_t)MT * FF * 2);
constexpr size_t WS_VB = AL(WS_KB + (size_t)3 * MP * 1024 * 2);
constexpr size_t WS_QB = AL(WS_VB + (size_t)3 * MP * 1024 * 2);
constexpr size_t WS_OG = AL(WS_QB + (size_t)3 * MP * 1024 * 2);
constexpr size_t WS_LSE = AL(WS_OG + (size_t)3 * MP * 1024 * 2);
constexpr size_t WS_OB = AL(WS_LSE + (size_t)3 * MP * 16 * 4);
constexpr size_t WS_QS = AL(WS_OB + (size_t)MT * 1024 * 2);
constexpr size_t WS_SSQ = AL(WS_QS + (size_t)256 * 3072 * 4);
constexpr size_t WS_ROPE = AL(WS_SSQ + (size_t)8 * MT * 4);
constexpr size_t WS_CTL = AL(WS_ROPE + (size_t)2 * 4104 * 32 * 4);
constexpr size_t CKV_ROWS = 136 + 520 + 1032;
constexpr size_t WS_CK = AL(WS_CTL + 32768);
constexpr size_t WS_CV = AL(WS_CK + (size_t)512 * CKV_ROWS * 64 * 2);
constexpr size_t WS_END = AL(WS_CV + (size_t)512 * CKV_ROWS * 64 * 2);

struct Params {
    const float *x_prompt, *x_sample, *state_pool, *cache0, *cache1, *cache2, *a_norm, *pool_w, *pool_scale, *kv_norm, *w_kv, *k_norm, *b_norm, *w_q, *q_norm, *w_o,
        *ffn_norm, *w_gate, *w_up, *w_down;
    float* out; unsigned char* ws; int lo, hi;
};

__device__ __forceinline__ int opaque_tid() { int t = threadIdx.x; asm volatile("" : "+v"(t)); return t; }
namespace pg8 {
#define PG8_LAS __attribute__((address_space(3)))
typedef unsigned short bf16_t;
typedef short bf16x8 __attribute__((ext_vector_type(8)));
typedef float f32x4 __attribute__((ext_vector_type(4)));
typedef unsigned u32x4 __attribute__((ext_vector_type(4)));
typedef unsigned u32x2 __attribute__((ext_vector_type(2)));
constexpr int BM = 256, BK = 64, HALF = 128, HTB = HALF * BK * 2  , STAGE_BYTES = 8 * HTB, NXCD = 8, WGM = 8;

__host__ __device__ __forceinline__ int lds_byte(int r, int c) { const int st = (r >> 4) * 2 + (c >> 5), rr = r & 15, cc = c & 31, ob = rr * 64 + cc * 2; return st * 1024 + (ob ^ (((ob >> 9) & 1) << 5)); }
__host__ __device__ __forceinline__ void stage_rc(int b, int& R, int& C) { const int st = b / 1024, sb = b % 1024, swz = sb ^ (((sb >> 9) & 1) << 5); R = (st >> 1) * 16 + swz / 64; C = (st & 1) * 32 + (swz % 64) / 2; }
__host__ __device__ __forceinline__ int perm32(int rho) { const int n = rho >> 4, i = rho & 15; return 8 * (i >> 2) + 4 * n + (i & 3); }

struct Unit { int pm, pn, rowt, colt; };
struct Gemm { const bf16_t* A; const bf16_t* Bt; int M, N, K; };

struct StaticOrder {
    int nM, nN, nwg, G, c, mode; unsigned* cnt;
    __device__ void init(int M, int N, int G_, int c_, int mode_) { nM = M / BM; nN = N / BM; nwg = nM * nN; G = G_; c = c_; mode = mode_; cnt = nullptr; }
    __device__ bool next(int i, Unit& u) const {
        if (mode == 4) { if (i > 0) return false; u.pm = nM; u.pn = c; u.rowt = nM; u.colt = c; return true; }
        const long L = (long)i * G + c;
        int wgid = (int)L, nw = nwg, nm = nM;
        if (mode == 3) {
            if (L >= nwg + nN) return false;
            if (L < nN) { u.pm = nM; u.pn = (int)L; u.rowt = nM; u.colt = (int)L; return true; }
            wgid -= nN;
        } else if (L >= nwg) return false;
        if (mode == 1) { const int g = wgid / NTM, m = wgid % NTM; u.pm = g * NTM + m; u.pn = g; u.rowt = m; u.colt = g; return true; }
        { const int q = nw / NXCD, r = nw % NXCD, xcd = wgid % NXCD, off = wgid / NXCD; wgid = (xcd < r ? xcd * (q + 1) : r * (q + 1) + (xcd - r) * q) + off; }
        const int nig = WGM * nN, gid = wgid / nig, fm = gid * WGM, gsz = (nm - fm) < WGM ? (nm - fm) : WGM;
        u.pm = fm + ((wgid % nig) % gsz); u.pn = (wgid % nig) / gsz; u.rowt = u.pm; u.colt = u.pn; return true;
    }
    __device__ __forceinline__ void a_ready(const Unit&) const {}
    __device__ __forceinline__ void done(const Unit& u) const {
        if (mode == 3 && u.rowt == nM) {
            asm volatile("s_waitcnt vmcnt(0)" ::: "memory");
            __builtin_amdgcn_s_barrier();
            if (threadIdx.x == 0) atomicAdd(cnt, 1u);
        }
    }
};

__device__ __forceinline__ unsigned cvt_pk_bf16(float lo, float hi) { unsigned r; asm volatile("v_cvt_pk_bf16_f32 %0, %1, %2" : "=v"(r) : "v"(lo), "v"(hi)); return r; }


struct EpiResid {
    static constexpr bool PERM = false, AFTER_DRAIN = false;
    const float* xin_p; const float* xin_s; float* X; const float* scale; bf16_t* xb; float* ssq;
    __device__ __forceinline__ void operator()(const f32x4 (&acc)[2][2][4][2], const Unit& u, int wr, int wc, int fr, int fq) const {
        const int colbase = u.colt * BM + wc * 32 + fq * 4;
        f32x4 sc[2][2];
#pragma unroll
        for (int bj = 0; bj < 2; ++bj)
#pragma unroll
            for (int n = 0; n < 2; ++n) sc[bj][n] = scale ? *(const f32x4*)(scale + colbase + bj * HALF + n * 16) : (f32x4){1.f, 1.f, 1.f, 1.f};
#pragma unroll
        for (int ai = 0; ai < 2; ++ai) {
            const int row0 = u.rowt * BM + ai * HALF + wr * 64 + fr;
            const float* xi0 = (row0 < MP) ? xin_p + (size_t)row0 * DM : xin_s + (size_t)(row0 - MP) * DM;
            f32x4 xv[4][2][2];
#pragma unroll
            for (int m = 0; m < 4; ++m)
#pragma unroll
                for (int bj = 0; bj < 2; ++bj)
#pragma unroll
                    for (int n = 0; n < 2; ++n) xv[m][bj][n] = *(const f32x4*)(xi0 + (size_t)m * 16 * DM + colbase + bj * HALF + n * 16);
            asm volatile("" ::: "memory");
#pragma unroll
            for (int m = 0; m < 4; ++m) {
                const int row = row0 + m * 16;
                float* xo = X + (size_t)row * DM; float ss = 0.f;
#pragma unroll
                for (int bj = 0; bj < 2; ++bj)
#pragma unroll
                    for (int n = 0; n < 2; ++n) {
                        const int col = colbase + bj * HALF + n * 16;
                        const f32x4 v = xv[m][bj][n] + acc[ai][bj][m][n] * sc[bj][n];
                        *(f32x4*)(xo + col) = v;
                        if (xb) { u32x2 w; w.x = cvt_pk_bf16(v[0], v[1]); w.y = cvt_pk_bf16(v[2], v[3]); *(u32x2*)(xb + (size_t)row * DM + col) = w; }
                        ss += (v[0] * v[0] + v[1] * v[1]) + (v[2] * v[2] + v[3] * v[3]);
                    }
                if (ssq) { ss += __shfl_xor(ss, 16); ss += __shfl_xor(ss, 32); if (fq == 0) atomicAdd(ssq + row, ss); }
            }
            asm volatile("" ::: "memory");
        }
    }
};

struct EpiGU {
    static constexpr bool PERM = false, AFTER_DRAIN = false;
    const float* ssq; bf16_t* H;
    __device__ __forceinline__ void operator()(const f32x4 (&acc)[2][2][4][2], const Unit& u, int wr, int wc, int fr, int fq) const {
        float rsv[2][4];
#pragma unroll
        for (int ai = 0; ai < 2; ++ai)
#pragma unroll
            for (int m = 0; m < 4; ++m) rsv[ai][m] = ssq[u.rowt * BM + ai * HALF + wr * 64 + m * 16 + fr];
#pragma unroll
        for (int ai = 0; ai < 2; ++ai)
#pragma unroll
            for (int m = 0; m < 4; ++m) {
                const int row = u.rowt * BM + ai * HALF + wr * 64 + m * 16 + fr;
                const float rs = __builtin_amdgcn_rsqf(rsv[ai][m] * (1.0f / DM) + EPS);
#pragma unroll
                for (int bj = 0; bj < 2; ++bj) {
                    const int hcol = u.colt * 128 + bj * 64 + wc * 16 + fq * 4;
                    const f32x4 g = acc[ai][bj][m][0] * rs, up = acc[ai][bj][m][1] * rs; float o[4];
#pragma unroll
                    for (int e = 0; e < 4; ++e) { const float sg = __builtin_amdgcn_rcpf(1.0f + __builtin_amdgcn_exp2f(-1.4426950408889634f * g[e])); o[e] = g[e] * sg * up[e]; }
                    u32x2 w; w.x = cvt_pk_bf16(o[0], o[1]); w.y = cvt_pk_bf16(o[2], o[3]);
                    if (u.rowt == MP / BM) __hip_atomic_store((unsigned long long*)(H + (size_t)row * FF + hcol), ((unsigned long long)w.y << 32) | (unsigned long long)w.x, __ATOMIC_RELAXED, __HIP_MEMORY_SCOPE_AGENT);
                    else *(u32x2*)(H + (size_t)row * FF + hcol) = w;
                }
            }
    }
};

__device__ __forceinline__ size_t hm_off(int g, int row, int h) {
    const int pos = row & (SEQ - 1), b = row >> 12, sh = 2 * g;
    const int sig = ((pos & ((1 << sh) - 1)) << (12 - sh)) + (pos >> sh);
    return ((size_t)((g * 4 + b) * 16 + h) * SEQ + sig) * 64;
}
__device__ __forceinline__ size_t ckv_off(int g, int n, int h, int idxc) {
    const size_t gbase = g == 0 ? 0 : (g == 1 ? (size_t)512 * 136 : (size_t)512 * (136 + 520));
    const int rc = g == 0 ? 136 : (g == 1 ? 520 : 1032);
    return (gbase + (size_t)(n * 16 + h) * rc + idxc) * 64;
}
struct EpiQKV {
    static constexpr bool PERM = false, AFTER_DRAIN = false;
    const float* ssq; int tile_base; const float* k_norm; const float* q_norm; const float* ropec; const float* ropes;
    bf16_t* Kb; bf16_t* Vb; bf16_t* Qb; float* QS; float* out; bf16_t* CK; bf16_t* CV;
    __device__ __forceinline__ void operator()(const f32x4 (&acc)[2][2][4][2], const Unit& u, int wr, int wc, int fr, int fq) const {
        const int tile = u.colt + tile_base, type = tile / 12, G = 4 * (tile % 12) + wc, g = G >> 4, h = G & 15;
        const int hist = 128 << (2 * g);
        const float* gn = (type == 0 ? k_norm : q_norm) + g * 64;
        const size_t okp = g == 0 ? O_KP0 : (g == 1 ? O_KP1 : O_KP2), oks = g == 0 ? O_KS0 : (g == 1 ? O_KS1 : O_KS2);
        f32x4 gA[2], gB[2];
#pragma unroll
        for (int n = 0; n < 2; ++n) { gA[n] = *(const f32x4*)(gn + n * 16 + fq * 4); gB[n] = *(const f32x4*)(gn + 32 + n * 16 + fq * 4); }
#pragma unroll
        for (int ai = 0; ai < 2; ++ai)
#pragma unroll
            for (int mh = 0; mh < 2; ++mh) {
                float sq[2]; f32x4 cs[2][2], sn[2][2];
#pragma unroll
                for (int mm = 0; mm < 2; ++mm) {
                    const int row = u.rowt * BM + ai * HALF + wr * 64 + (2 * mh + mm) * 16 + fr;
                    sq[mm] = ssq[row];
                    if (type != 1) {
                        const int pi = row < MP ? (row & (SEQ - 1)) : SEQ + ((row - MP) & 7);
#pragma unroll
                        for (int n = 0; n < 2; ++n) { cs[mm][n] = *(const f32x4*)(ropec + pi * 32 + n * 16 + fq * 4); sn[mm][n] = *(const f32x4*)(ropes + pi * 32 + n * 16 + fq * 4); }
                    }
                }
                asm volatile("" ::: "memory");
#pragma unroll
                for (int mm = 0; mm < 2; ++mm) {
                    const int m = 2 * mh + mm;
                    const int row = u.rowt * BM + ai * HALF + wr * 64 + m * 16 + fr;
                    const float rs = __builtin_amdgcn_rsqf(sq[mm] * (1.0f / DM) + EPS);
                    f32x4 v[2][2];
#pragma unroll
                    for (int bj = 0; bj < 2; ++bj)
#pragma unroll
                        for (int n = 0; n < 2; ++n) v[bj][n] = acc[ai][bj][m][n] * rs;
                    if (type != 1) {
                        float ss = 0.f;
#pragma unroll
                        for (int bj = 0; bj < 2; ++bj)
#pragma unroll
                            for (int n = 0; n < 2; ++n) ss += (v[bj][n][0] * v[bj][n][0] + v[bj][n][1] * v[bj][n][1]) + (v[bj][n][2] * v[bj][n][2] + v[bj][n][3] * v[bj][n][3]);
                        ss += __shfl_xor(ss, 16); ss += __shfl_xor(ss, 32);
                        float hr = __builtin_amdgcn_rsqf(ss * (1.0f / 64.0f) + EPS);
                        if (type == 2) hr *= C2;
#pragma unroll
                        for (int n = 0; n < 2; ++n) {
                            const f32x4 a = v[0][n] * hr * gA[n], b = v[1][n] * hr * gB[n];
                            v[0][n] = a * cs[mm][n] - b * sn[mm][n]; v[1][n] = b * cs[mm][n] + a * sn[mm][n];
                        }
                    }
#pragma unroll
                    for (int bj = 0; bj < 2; ++bj)
#pragma unroll
                        for (int n = 0; n < 2; ++n) {
                            const int d = bj * 32 + n * 16 + fq * 4; const f32x4 x = v[bj][n];
                            u32x2 w; w.x = cvt_pk_bf16(x[0], x[1]); w.y = cvt_pk_bf16(x[2], x[3]);
                            if (type == 2) {
                                if (row < MP) *(u32x2*)(Qb + hm_off(g, row, h) + d) = w;
                                else *(f32x4*)(QS + (size_t)(row - MP) * 3072 + G * 64 + d) = x;
                            } else {
                                if (row < MP) {
                                    *(u32x2*)((type == 0 ? Kb : Vb) + hm_off(g, row, h) + d) = w;
                                    const int s = row & (SEQ - 1), b = row >> 12;
                                    if (s >= SEQ - hist) *(f32x4*)(out + okp + ((size_t)(b * hist + s - (SEQ - hist)) * 2 + type) * DM + h * 64 + d) = x;
                                } else {
                                    const int q = row - MP, n_ = q >> 3, t = q & 7;
                                    *(f32x4*)(out + oks + ((size_t)(n_ * hist + hist - 8 + t) * 2 + type) * DM + h * 64 + d) = x;
                                    *(u32x2*)((type == 0 ? CK : CV) + ckv_off(g, n_, h, (g == 2 ? 1024 : hist) + t) + d) = w;
                                }
                            }
                        }
                }
                asm volatile("" ::: "memory");
            }
    }
};

template <class Epi, class Sched, bool ALIGN_EPI = false, bool SP2 = false>
__device__ __forceinline__ void gemm_phase(PG8_LAS unsigned char* lds, const Gemm g, const Sched& S, const Epi& E) {
    const int tid = opaque_tid(), wid = __builtin_amdgcn_readfirstlane(tid >> 6), lane = tid & 63, wr = wid >> 2, wc = wid & 3, fr = lane & 15, fq = lane >> 4;
    const int K = g.K, nt = K / BK;
    unsigned voffA[2], voffB[2];
#pragma unroll
    for (int i = 0; i < 2; ++i) { int R, C; stage_rc(tid * 16 + i * 8192, R, C); const int Rb = Epi::PERM ? ((R & ~31) + perm32(R & 31)) : R;
        voffA[i] = (unsigned)(R * K + C) * 2u; voffB[i] = (unsigned)(Rb * K + C) * 2u; }
    const size_t kstep = (size_t)(BK * 2);
    const size_t hstep = (size_t)HALF * K * 2;
    const size_t tstep = 2 * hstep;
    const unsigned ldsw = (unsigned)wid * 1024u;
    const int aoff = lds_byte(wr * 64 + fr, fq * 8), boff = lds_byte(wc * 32 + fr, fq * 8);
#define PG8_SA(b, h) (((b) * 2 + (h)) * HTB)
#define PG8_SB(b, h) ((4 + (b) * 2 + (h)) * HTB)
#define PG8_STAGE(bufoff, gbase, voff) do { _Pragma("unroll") for (int _i = 0; _i < 2; ++_i) \
        __builtin_amdgcn_global_load_lds((const unsigned*)((const char*)(gbase) + (voff)[_i]), (PG8_LAS unsigned*)(lds + (bufoff) + ldsw + _i * 8192), 16, 0, 0); } while (0)
#define PG8_LDA(dst, b, h) do { _Pragma("unroll") for (int m = 0; m < 4; ++m) _Pragma("unroll") for (int k = 0; k < 2; ++k) dst[m][k] = *(const PG8_LAS bf16x8*)(lds + PG8_SA(b, h) + aoff + m * 2048 + k * 1024); } while (0)
#define PG8_LDB(dst, b, h) do { _Pragma("unroll") for (int n = 0; n < 2; ++n) _Pragma("unroll") for (int k = 0; k < 2; ++k) dst[n][k] = *(const PG8_LAS bf16x8*)(lds + PG8_SB(b, h) + boff + n * 2048 + k * 1024); } while (0)
#define PG8_MMA(ai, bj, At, Bt) do { __builtin_amdgcn_s_setprio(1); _Pragma("unroll") for (int m = 0; m < 4; ++m) _Pragma("unroll") for (int n = 0; n < 2; ++n) _Pragma("unroll") for (int k = 0; k < 2; ++k) \
        acc[ai][bj][m][n] = __builtin_amdgcn_mfma_f32_16x16x32_bf16(Bt[n][k], At[m][k], acc[ai][bj][m][n], 0, 0, 0); __builtin_amdgcn_s_setprio(0); } while (0)
#define PG8_WAIT_V(n) asm volatile("s_waitcnt vmcnt(" #n ")" ::: "memory")
#define PG8_WAIT_L(n) asm volatile("s_waitcnt lgkmcnt(" #n ")" ::: "memory")
#define PG8_BAR __builtin_amdgcn_s_barrier()
#define PG8_SCHED __builtin_amdgcn_sched_barrier(0)
    Unit cur, nxt; int ui = 0;
    if (!S.next(0, cur)) return;
    f32x4 acc[2][2][4][2];
#pragma unroll
    for (int a = 0; a < 2; ++a)
#pragma unroll
        for (int b = 0; b < 2; ++b)
#pragma unroll
            for (int m = 0; m < 4; ++m)
#pragma unroll
                for (int n = 0; n < 2; ++n) acc[a][b][m][n] = (f32x4){0.f, 0.f, 0.f, 0.f};
    bf16x8 At[4][2], B0[2][2], B1[2][2];
    const char* cA = (const char*)g.A + (size_t)cur.pm * tstep; const char* cB = (const char*)g.Bt + (size_t)cur.pn * tstep;
    S.a_ready(cur);
    if constexpr (SP2) {
        PG8_STAGE(PG8_SB(0, 0), cB, voffB); PG8_STAGE(PG8_SB(0, 1), cB + hstep, voffB); PG8_STAGE(PG8_SA(0, 0), cA, voffA); PG8_STAGE(PG8_SA(0, 1), cA + hstep, voffA);
        if (wr == 1) PG8_BAR;
        PG8_WAIT_V(2); PG8_BAR;
        PG8_STAGE(PG8_SB(1, 0), cB + kstep, voffB); PG8_STAGE(PG8_SA(1, 0), cA + kstep, voffA); PG8_STAGE(PG8_SB(1, 1), cB + hstep + kstep, voffB);
        PG8_WAIT_V(6); PG8_BAR;
    } else {
        PG8_STAGE(PG8_SB(0, 0), cB, voffB); PG8_STAGE(PG8_SA(0, 0), cA, voffA); PG8_STAGE(PG8_SB(0, 1), cB + hstep, voffB); PG8_STAGE(PG8_SA(0, 1), cA + hstep, voffA);
        if (wr == 1) PG8_BAR;
        PG8_WAIT_V(4); PG8_BAR;
        PG8_STAGE(PG8_SB(1, 0), cB + kstep, voffB); PG8_STAGE(PG8_SA(1, 0), cA + kstep, voffA); PG8_STAGE(PG8_SB(1, 1), cB + hstep + kstep, voffB);
        PG8_WAIT_V(6); PG8_BAR;
    }
    for (;;) {
        const bool has_next = S.next(ui + 1, nxt);
        const char* nA = has_next ? (const char*)g.A + (size_t)nxt.pm * tstep : cA; const char* nB = has_next ? (const char*)g.Bt + (size_t)nxt.pn * tstep : cB;
        for (int t = 0; t < nt; t += 2) {
            const bool last = (t == nt - 2);
            const char* a1 = cA + (size_t)(t + 1) * kstep;
            const char* a2 = last ? nA : cA + (size_t)(t + 2) * kstep; const char* b2 = last ? nB : cB + (size_t)(t + 2) * kstep;
            const char* a3 = a2 + kstep; const char* b3 = b2 + kstep;
            if (last && has_next) S.a_ready(nxt);
            if constexpr (SP2) {
            PG8_LDB(B0, 0, 0); PG8_LDB(B1, 0, 1); PG8_SCHED; PG8_LDA(At, 0, 0); PG8_STAGE(PG8_SA(1, 1), a1 + hstep, voffA);
            PG8_WAIT_V(8); PG8_WAIT_L(0); PG8_BAR; PG8_MMA(0, 0, At, B0); PG8_MMA(0, 1, At, B1); PG8_BAR; PG8_SCHED;
            PG8_LDA(At, 0, 1); PG8_STAGE(PG8_SB(0, 0), b2, voffB); PG8_STAGE(PG8_SB(0, 1), b2 + hstep, voffB); PG8_STAGE(PG8_SA(0, 0), a2, voffA);
            PG8_WAIT_V(8); PG8_WAIT_L(0); PG8_BAR; PG8_MMA(1, 0, At, B0); PG8_MMA(1, 1, At, B1); PG8_BAR; PG8_SCHED;
            PG8_LDB(B0, 1, 0); PG8_LDB(B1, 1, 1); PG8_SCHED; PG8_LDA(At, 1, 0); PG8_STAGE(PG8_SA(0, 1), a2 + hstep, voffA);
            PG8_WAIT_V(8); PG8_WAIT_L(0); PG8_BAR; PG8_MMA(0, 0, At, B0); PG8_MMA(0, 1, At, B1); PG8_BAR; PG8_SCHED;
            PG8_LDA(At, 1, 1); PG8_STAGE(PG8_SB(1, 0), b3, voffB); PG8_STAGE(PG8_SB(1, 1), b3 + hstep, voffB); PG8_STAGE(PG8_SA(1, 0), a3, voffA);
            PG8_WAIT_V(8); PG8_WAIT_L(0); PG8_BAR; PG8_MMA(1, 0, At, B0); PG8_MMA(1, 1, At, B1); PG8_BAR; PG8_SCHED;
            } else {
            PG8_LDB(B0, 0, 0); PG8_SCHED; PG8_LDA(At, 0, 0); PG8_STAGE(PG8_SA(1, 1), a1 + hstep, voffA);
            PG8_WAIT_L(8); PG8_BAR; PG8_WAIT_L(0); PG8_MMA(0, 0, At, B0); PG8_BAR; PG8_SCHED;
            PG8_LDB(B1, 0, 1); PG8_STAGE(PG8_SB(0, 0), b2, voffB);
            PG8_BAR; PG8_WAIT_L(0); PG8_MMA(0, 1, At, B1); PG8_BAR;
            PG8_LDA(At, 0, 1); PG8_STAGE(PG8_SA(0, 0), a2, voffA);
            PG8_BAR; PG8_WAIT_L(0); PG8_MMA(1, 0, At, B0); PG8_BAR; PG8_SCHED;
            PG8_STAGE(PG8_SB(0, 1), b2 + hstep, voffB);
            PG8_WAIT_V(6); PG8_BAR; PG8_MMA(1, 1, At, B1); PG8_BAR;
            PG8_LDB(B0, 1, 0); PG8_SCHED; PG8_LDA(At, 1, 0); PG8_STAGE(PG8_SA(0, 1), a2 + hstep, voffA);
            PG8_WAIT_L(8); PG8_BAR; PG8_WAIT_L(0); PG8_MMA(0, 0, At, B0); PG8_BAR; PG8_SCHED;
            PG8_LDB(B1, 1, 1); PG8_STAGE(PG8_SB(1, 0), b3, voffB);
            PG8_BAR; PG8_WAIT_L(0); PG8_MMA(0, 1, At, B1); PG8_BAR;
            PG8_LDA(At, 1, 1); PG8_STAGE(PG8_SA(1, 0), a3, voffA);
            PG8_BAR; PG8_WAIT_L(0); PG8_MMA(1, 0, At, B0); PG8_BAR; PG8_SCHED;
            PG8_STAGE(PG8_SB(1, 1), b3 + hstep, voffB);
            PG8_WAIT_V(6); PG8_BAR; PG8_MMA(1, 1, At, B1); PG8_BAR;
            }
        }
        if constexpr (ALIGN_EPI) { if (wr == 0) PG8_BAR; }
        if constexpr (!Epi::AFTER_DRAIN) { E(acc, cur, wr, wc, fr, fq); S.done(cur); }
        if (!has_next) break;
#pragma unroll
        for (int a = 0; a < 2; ++a)
#pragma unroll
            for (int b = 0; b < 2; ++b)
#pragma unroll
                for (int m = 0; m < 4; ++m)
#pragma unroll
                    for (int n = 0; n < 2; ++n) acc[a][b][m][n] = (f32x4){0.f, 0.f, 0.f, 0.f};
        cur = nxt; cA = nA; cB = nB; ++ui;
        if constexpr (ALIGN_EPI) { if (wr == 1) PG8_BAR; }
    }
    PG8_WAIT_V(0);
    if constexpr (!ALIGN_EPI) { if (wr == 0) PG8_BAR; }
    PG8_BAR;
    if constexpr (Epi::AFTER_DRAIN) { E.fused(acc, cur, wr, wc, fr, fq, lds, wid, lane); S.done(cur); }
#undef PG8_SA
#undef PG8_SB
#undef PG8_STAGE
#undef PG8_LDA
#undef PG8_LDB
#undef PG8_MMA
#undef PG8_WAIT_V
#undef PG8_WAIT_L
#undef PG8_BAR
#undef PG8_SCHED
}
}

#define LAS __attribute__((address_space(3)))
typedef unsigned short bf16_t;
typedef short bf16x8 __attribute__((ext_vector_type(8)));
typedef short s16x4 __attribute__((ext_vector_type(4)));
typedef float f32x4 __attribute__((ext_vector_type(4)));
typedef float f32x16 __attribute__((ext_vector_type(16)));
typedef unsigned u32x4 __attribute__((ext_vector_type(4)));
typedef unsigned u32x2 __attribute__((ext_vector_type(2)));
constexpr int NWAVES = 8, NTHREADS = 512;
constexpr int LDS_BYTES = 147456;

__device__ __forceinline__ unsigned pk_bf16(float lo, float hi) { return pg8::cvt_pk_bf16(lo, hi); }

__constant__ double INV_FREQ[32] = {1.0, 0.7498942093324559, 0.5623413251903491, 0.4216965034285822, 0.31622776601683794, 0.23713737056616552, 0.1778279410038923, 0.1333521432163324, 0.1,
    0.07498942093324558, 0.05623413251903491, 0.042169650342858224, 0.03162277660168379, 0.023713737056616554, 0.01778279410038923, 0.01333521432163324, 0.01, 0.007498942093324558,
    0.005623413251903491, 0.004216965034285823, 0.0031622776601683794, 0.0023713737056616554, 0.0017782794100389228, 0.001333521432163324, 0.001, 0.0007498942093324559,
    0.0005623413251903491, 0.00042169650342858224, 0.00031622776601683794, 0.00023713737056616554, 0.00017782794100389227, 0.0001333521432163324};

__device__ __forceinline__ void wconv_item(const float* src, const float* src2, int K, int Nsrc, bf16_t* dst, int Ndst, int mode, const float* gain, LAS float* scr, int item, int lane) {
    const int nblk = Ndst / 32, kb = item / nblk, nb = item % nblk, k0 = 64 * kb, n0 = 32 * nb;
    const int np = n0 + (lane & 31);
    const float* s = src; int col = np;
    if (mode == 1) { col = (np >> 5) * 16 + (np & 15); if ((np >> 4) & 1) s = src2; }
    else if (mode == 2) { const int pn = np >> 8, bj = (np >> 7) & 1, wc = (np >> 5) & 3, j = np & 31; col = (4 * pn + wc) * 64 + 32 * bj + j; }
    float wv[32];
#pragma unroll
    for (int i = 0; i < 32; ++i) { const int kk = 2 * i + (lane >> 5); wv[i] = s[(size_t)(k0 + kk) * Nsrc + col]; }
    if (gain) {
#pragma unroll
        for (int i = 0; i < 32; ++i) { const int kk = 2 * i + (lane >> 5); wv[i] *= gain[k0 + kk]; }
    }
#pragma unroll
    for (int i = 0; i < 32; ++i) { const int kk = 2 * i + (lane >> 5); scr[kk * 33 + (lane & 31)] = wv[i]; }
    asm volatile("s_waitcnt lgkmcnt(0)" ::: "memory");
    const int c = lane & 7;
#pragma unroll
    for (int j = 0; j < 4; ++j) { const int n = (lane >> 3) + 8 * j; const LAS float* t = scr + (8 * c) * 33 + n;
        u32x4 o; o.x = pk_bf16(t[0 * 33], t[1 * 33]); o.y = pk_bf16(t[2 * 33], t[3 * 33]); o.z = pk_bf16(t[4 * 33], t[5 * 33]); o.w = pk_bf16(t[6 * 33], t[7 * 33]);
        *(u32x4*)(dst + (size_t)(n0 + n) * K + k0 + 8 * c) = o; }
    asm volatile("s_waitcnt lgkmcnt(0)" ::: "memory");
}

__device__ __forceinline__ void prep_weights(const Params& p, LAS unsigned char* lds, int gw, int NGW, int wave, int lane) {
    LAS float* scr = (LAS float*)(lds + wave * 8704);
    unsigned char* ws = p.ws;
    constexpr int NITEMS_ALL = 8 * 32 + 4 * 2816 + 4 * 1408 + 3072 + 2 * 1536 + 2 * 512;
    for (int gi = gw; gi < NITEMS_ALL; gi += NGW) {
        int id = 0, it = gi;
        for (;;) { const int ni = id < 8 ? 32 : (id < 12 ? 2816 : (id < 16 ? 1408 : (id == 16 ? 3072 : (id < 19 ? 1536 : 512)))); if (it < ni) break; it -= ni; ++id; }
        const float* src; const float* src2 = nullptr; int K, Nsrc, Ndst, mode = 0; bf16_t* dst; const float* gain = nullptr;
        if (id < 8) { src = p.pool_w + (size_t)id * 65536; K = 256; Nsrc = 256; Ndst = 256; dst = (bf16_t*)(ws + WS_WPOOL) + (size_t)id * 65536; }
        else if (id < 12) { const int l = id - 8; src = p.w_gate + (size_t)l * DM * FF; src2 = p.w_up + (size_t)l * DM * FF; K = DM; Nsrc = FF; Ndst = 2 * FF; mode = 1;
                            dst = (bf16_t*)(ws + WS_WGU) + (size_t)l * 2 * FF * DM; gain = p.ffn_norm + l * DM; }
        else if (id < 16) { const int l = id - 12; src = p.w_down + (size_t)l * FF * DM; K = FF; Nsrc = DM; Ndst = DM; dst = (bf16_t*)(ws + WS_WDN) + (size_t)l * DM * FF; }
        else if (id == 16) { src = p.w_kv; K = DM; Nsrc = 6144; Ndst = 6144; mode = 2; dst = (bf16_t*)(ws + WS_WKVQ); gain = p.kv_norm; }
        else if (id == 17) { src = p.w_q; K = DM; Nsrc = 3072; Ndst = 3072; mode = 2; dst = (bf16_t*)(ws + WS_WKVQ) + (size_t)6144 * DM; gain = p.b_norm; }
        else if (id == 18) { src = p.w_q + (size_t)DM * 3072; K = DM; Nsrc = 3072; Ndst = 3072; mode = 2; dst = (bf16_t*)(ws + WS_WQ1); gain = p.b_norm + DM; }
        else { const int j = id - 19; src = p.w_o + (size_t)j * DM * DM; K = DM; Nsrc = DM; Ndst = DM; dst = (bf16_t*)(ws + WS_WO) + (size_t)j * DM * DM; }
        wconv_item(src, src2, K, Nsrc, dst, Ndst, mode, gain, scr, it, lane);
    }
}

template <int W> __device__ __forceinline__ void pool_rows_prompt(const Params& p, int layer, const float* xp, const LAS float* rst, int t0, int half, int c4, int g, f32x4 gn, bf16_t* Dbuf) {
    const int rfirst = t0 + half * 16, r0 = rfirst - (W - 1), bstart = t0 & ~(SEQ - 1);
    f32x4 u[W + 15];
    const float* xr = xp + (size_t)r0 * DM + c4;
#pragma unroll
    for (int k = 0; k < W + 15; ++k) { const int r = r0 + k; u[k] = (f32x4){0.f, 0.f, 0.f, 0.f}; if (r >= bstart) u[k] = *(const f32x4*)xr; xr += DM; asm volatile("" : "+v"(xr)); }
#pragma unroll
    for (int k = 0; k < W + 15; ++k) { const int r = r0 + k; if (r >= bstart) u[k] = u[k] * rst[r - (t0 - 15)] * gn; }
    f32x4 S = {0.f, 0.f, 0.f, 0.f};
#pragma unroll
    for (int k = 0; k < W - 1; ++k) S += u[k];
#pragma unroll
    for (int i = 0; i < 16; ++i) {
        const int r = rfirst + i; const f32x4 uu = u[W - 1 + i];
        S += uu;
        const int s1 = (r & (SEQ - 1)) + 1; const int cnt = s1 < W ? s1 : W;
        const f32x4 d = S * (1.0f / (float)cnt) - uu;
        u32x2 wv; wv.x = pk_bf16(d[0], d[1]); wv.y = pk_bf16(d[2], d[3]);
        *(u32x2*)(Dbuf + ((size_t)g * MT + r) * 256 + (c4 - 256 * g)) = wv;
        const int s = r & (SEQ - 1), b = r >> 12;
        if (s >= SEQ - 15) *(f32x4*)(p.out + O_PP + ((size_t)(b * 2 + layer) * 15 + (s - (SEQ - 15))) * DM + c4) = uu;
        S -= u[i];
    }
}
template <int W> __device__ __forceinline__ void pool_rows_sample(const Params& p, int layer, const float* xs, const LAS float* rst, int n, int half, int c4, int g, f32x4 gn, bf16_t* Dbuf) {
    const int e0 = 15 + 4 * half - (W - 1);
    const float* sp = p.state_pool + (size_t)(n * 2 + layer) * 15 * DM + c4;
    f32x4 u[W + 3];
#pragma unroll
    for (int k = 0; k < W + 3; ++k) { const int e = e0 + k; u[k] = (e < 15) ? *(const f32x4*)(sp + (size_t)e * DM) : *(const f32x4*)(xs + (size_t)(n * 8 + e - 15) * DM + c4) * rst[e - 15] * gn; }
    f32x4 S = {0.f, 0.f, 0.f, 0.f};
#pragma unroll
    for (int k = 0; k < W - 1; ++k) S += u[k];
    float* po = p.out + O_PS + (size_t)(n * 2 + layer) * 15 * DM + c4;
#pragma unroll
    for (int i = 0; i < 4; ++i) {
        const int t = 4 * half + i, r = MP + n * 8 + t; const f32x4 uu = u[W - 1 + i];
        S += uu;
        const f32x4 d = S * (1.0f / (float)W) - uu;
        u32x2 wv; wv.x = pk_bf16(d[0], d[1]); wv.y = pk_bf16(d[2], d[3]);
        *(u32x2*)(Dbuf + ((size_t)g * MT + r) * 256 + (c4 - 256 * g)) = wv;
        *(f32x4*)(po + (size_t)(7 + t) * DM) = uu;
        S -= u[i];
    }
    if (half == 0) {
#pragma unroll
        for (int k = 0; k < 7; ++k) *(f32x4*)(po + (size_t)k * DM) = *(const f32x4*)(sp + (size_t)(8 + k) * DM);
    }
}
__device__ __forceinline__ float row_ssq3(const float* r0, const float* r1, const float* r2, int lane, float& s1, float& s2) {
    f32x4 v[12];
#pragma unroll
    for (int j = 0; j < 4; ++j) { v[j] = *(const f32x4*)(r0 + 4 * lane + 256 * j); v[4 + j] = *(const f32x4*)(r1 + 4 * lane + 256 * j); v[8 + j] = *(const f32x4*)(r2 + 4 * lane + 256 * j); }
    float a = 0.f, b = 0.f, c = 0.f;
#pragma unroll
    for (int j = 0; j < 4; ++j) { a += (v[j][0] * v[j][0] + v[j][1] * v[j][1]) + (v[j][2] * v[j][2] + v[j][3] * v[j][3]);
        b += (v[4 + j][0] * v[4 + j][0] + v[4 + j][1] * v[4 + j][1]) + (v[4 + j][2] * v[4 + j][2] + v[4 + j][3] * v[4 + j][3]);
        c += (v[8 + j][0] * v[8 + j][0] + v[8 + j][1] * v[8 + j][1]) + (v[8 + j][2] * v[8 + j][2] + v[8 + j][3] * v[8 + j][3]); }
#pragma unroll
    for (int o = 1; o < 64; o <<= 1) { a += __shfl_xor(a, o); b += __shfl_xor(b, o); c += __shfl_xor(c, o); }
    s1 = b; s2 = c; return a;
}
__device__ __forceinline__ void pool_prep(const Params& p, int layer, LAS unsigned char* lds) {
    const int tid = opaque_tid(), lane = tid & 63, wave = tid >> 6;
    LAS float* rst = (LAS float*)(lds + 73728);
    const float* xp = layer == 0 ? p.x_prompt : p.out + O_YP;
    const float* xs = layer == 0 ? p.x_sample : p.out + O_YS;
    const float* gain = p.a_norm + layer * DM;
    bf16_t* Dbuf = (bf16_t*)(p.ws + WS_DBUF);
    const int c4 = (tid & 255) * 4, half = tid >> 8, g = (tid & 255) >> 6;
    const f32x4 gn = *(const f32x4*)(gain + c4);
    const int vblk = (gridDim.x & 7) == 0 ? (int)((blockIdx.x & 7) * (gridDim.x >> 3) + (blockIdx.x >> 3)) : (int)blockIdx.x;
    for (int it = vblk; it < MP / 32; it += gridDim.x) {
        {
            const int t0 = it * 32;
            const bool halo = (t0 & (SEQ - 1)) != 0;
#pragma unroll
            for (int bt = 0; bt < 2; ++bt) {
                int rr[3]; const float* rp[3];
#pragma unroll
                for (int q = 0; q < 3; ++q) { rr[q] = wave + 8 * (3 * bt + q); int r = t0 - 15 + rr[q]; const bool ok = rr[q] < 47 && (rr[q] >= 15 || halo); if (!ok) r = t0; rp[q] = xp + (size_t)r * DM; }
                float s1, s2; const float s0 = row_ssq3(rp[0], rp[1], rp[2], lane, s1, s2);
                if (lane == 0) { if (rr[0] < 47) rst[rr[0]] = 1.0f / sqrtf(s0 * (1.0f / DM) + EPS); if (rr[1] < 47) rst[rr[1]] = 1.0f / sqrtf(s1 * (1.0f / DM) + EPS); if (rr[2] < 47) rst[rr[2]] = 1.0f / sqrtf(s2 * (1.0f / DM) + EPS); }
            }
            __syncthreads();
            if (g == 0) pool_rows_prompt<2>(p, layer, xp, rst, t0, half, c4, g, gn, Dbuf);
            else if (g == 1) pool_rows_prompt<4>(p, layer, xp, rst, t0, half, c4, g, gn, Dbuf);
            else if (g == 2) pool_rows_prompt<8>(p, layer, xp, rst, t0, half, c4, g, gn, Dbuf);
            else pool_rows_prompt<16>(p, layer, xp, rst, t0, half, c4, g, gn, Dbuf);
        }
        __syncthreads();
    }
    for (int it = gridDim.x - 1 - blockIdx.x; it < 32; it += gridDim.x) {
        {
            const int n = it;
            { const float* row = xs + (size_t)(n * 8 + wave) * DM; float ss = 0.f;
#pragma unroll
              for (int j = 0; j < 4; ++j) { const f32x4 v = *(const f32x4*)(row + 4 * lane + 256 * j); ss += (v[0] * v[0] + v[1] * v[1]) + (v[2] * v[2] + v[3] * v[3]); }
#pragma unroll
              for (int o = 1; o < 64; o <<= 1) ss += __shfl_xor(ss, o);
              if (lane == 0) rst[wave] = 1.0f / sqrtf(ss * (1.0f / DM) + EPS); }
            __syncthreads();
            if (g == 0) pool_rows_sample<2>(p, layer, xs, rst, n, half, c4, g, gn, Dbuf);
            else if (g == 1) pool_rows_sample<4>(p, layer, xs, rst, n, half, c4, g, gn, Dbuf);
            else if (g == 2) pool_rows_sample<8>(p, layer, xs, rst, n, half, c4, g, gn, Dbuf);
            else pool_rows_sample<16>(p, layer, xs, rst, n, half, c4, g, gn, Dbuf);
        }
        __syncthreads();
    }
}

__device__ __forceinline__ void phase_prep(const Params& p, LAS unsigned char* lds) {
    const int tid = opaque_tid(), lane = tid & 63, wave = tid >> 6;
    const int gw = blockIdx.x * NWAVES + wave, NGW = gridDim.x * NWAVES;
    const size_t gt = (size_t)blockIdx.x * NTHREADS + tid, NGT = (size_t)gridDim.x * NTHREADS;
    prep_weights(p, lds, gw, NGW, wave, lane);
    { float* ssq = (float*)(p.ws + WS_SSQ); for (size_t i = gt; i < (size_t)8 * MT; i += NGT) ssq[i] = 0.f; }
    { float* rc = (float*)(p.ws + WS_ROPE); float* rs = rc + 4104 * 32;
      for (size_t i = gt; i < (size_t)4104 * 32; i += NGT) { const int pi = (int)(i >> 5), f = (int)(i & 31); const int pos = pi < SEQ ? pi : 8192 + (pi - SEQ);
          const double turns = (double)pos * INV_FREQ[f] * 0.15915494309189535; const double fr = turns - floor(turns);
          const float a = (float)(fr * 6.283185307179586); rc[i] = __builtin_amdgcn_cosf((float)fr); rs[i] = __builtin_amdgcn_sinf((float)fr); } }
    pool_prep(p, 0, lds);
}

__device__ __forceinline__ void phase_merge(const Params& p, int blk, int nblk) {
    const bf16_t* OG = (const bf16_t*)(p.ws + WS_OG); const float* LSE = (const float*)(p.ws + WS_LSE); bf16_t* OB = (bf16_t*)(p.ws + WS_OB);
    const size_t gt = (size_t)blk * NTHREADS + opaque_tid(), NGT = (size_t)nblk * NTHREADS;
    for (size_t i = gt; i < (size_t)MP * 128; i += NGT) {
        const size_t row = i >> 7; const int ch = (int)(i & 127), h = ch >> 3;
        const float l0 = LSE[(0 * (size_t)MP + row) * 16 + h], l1 = LSE[(1 * (size_t)MP + row) * 16 + h], l2 = LSE[(2 * (size_t)MP + row) * 16 + h];
        const float mx = fmaxf(l0, fmaxf(l1, l2));
        float w0 = __builtin_amdgcn_exp2f(l0 - mx), w1 = __builtin_amdgcn_exp2f(l1 - mx), w2 = __builtin_amdgcn_exp2f(l2 - mx);
        const float inv = 1.0f / (w0 + w1 + w2); w0 *= inv; w1 *= inv; w2 *= inv;
        const u32x4 a = *(const u32x4*)(OG + (0 * (size_t)MP + row) * DM + ch * 8), b = *(const u32x4*)(OG + (1 * (size_t)MP + row) * DM + ch * 8), c = *(const u32x4*)(OG + (2 * (size_t)MP + row) * DM + ch * 8);
        u32x4 o;
#pragma unroll
        for (int e = 0; e < 4; ++e) {
            const float lo = w0 * __uint_as_float(a[e] << 16) + w1 * __uint_as_float(b[e] << 16) + w2 * __uint_as_float(c[e] << 16);
            const float hi = w0 * __uint_as_float(a[e] & 0xffff0000u) + w1 * __uint_as_float(b[e] & 0xffff0000u) + w2 * __uint_as_float(c[e] & 0xffff0000u);
            o[e] = pk_bf16(lo, hi);
        }
        *(u32x4*)(OB + row * DM + ch * 8) = o;
    }
}

struct AttnGeom { int dil, r, c, rL; size_t base, lbase, hbase; };
__device__ __forceinline__ AttnGeom attn_geom(int u) {
    const int j5 = (u >> 3) & 31, rc = j5 & 15, h = 2 * (u & 7) + (j5 >> 4), b = (u >> 8) & 3, g = u >> 10;
    AttnGeom G; G.dil = 1 << (2 * g); G.r = rc & (G.dil - 1); G.c = rc >> (2 * g); G.rL = G.r << (12 - 2 * g);
    G.base = ((size_t)g * MP + (size_t)b * SEQ) * DM + h * 64; G.lbase = ((size_t)g * MP + (size_t)b * SEQ) * 16 + h;
    G.hbase = (size_t)((g * 4 + b) * 16 + h) * SEQ * 64; return G;
}
__device__ __forceinline__ void attn_load(const Params& p, int u, int tid, u32x4 (&kreg)[6], u32x4 (&vreg)[6]) {
    const AttnGeom G = attn_geom(u);
    const bf16_t* Kg = (const bf16_t*)(p.ws + WS_KB) + G.hbase; const bf16_t* Vg = (const bf16_t*)(p.ws + WS_VB) + G.hbase;
    const int ch = tid & 7;
#pragma unroll
    for (int k = 0; k < 6; ++k) {
        const int i = (tid >> 3) + 64 * k, kl = 256 * G.c - 128 + i;
        u32x4 kv = {0u, 0u, 0u, 0u}, vv = {0u, 0u, 0u, 0u};
        if (kl >= 0) { const size_t ro = (size_t)(G.rL + kl) * 64 + ch * 8; kv = *(const u32x4*)(Kg + ro); vv = *(const u32x4*)(Vg + ro); }
        kreg[k] = kv; vreg[k] = vv;
    }
}
__device__ __forceinline__ void attn_load_q(const Params& p, int u, int tid, bf16x8 (&qf)[4]) {
    const AttnGeom G = attn_geom(u);
    const bf16_t* Qg = (const bf16_t*)(p.ws + WS_QB) + G.hbase;
    const int lane = tid & 63, wave = tid >> 6, qi = lane & 31, hi = lane >> 5;
    const size_t qro = (size_t)(G.rL + 256 * G.c + 32 * wave + qi) * 64;
#pragma unroll
    for (int d0 = 0; d0 < 4; ++d0) qf[d0] = *(const bf16x8*)(Qg + qro + d0 * 16 + hi * 8);
}
__device__ __forceinline__ void attn_stage(int tid, LAS unsigned char* lds, const u32x4 (&kreg)[6], const u32x4 (&vreg)[6]) {
    const int ch = tid & 7;
#pragma unroll
    for (int k = 0; k < 6; ++k) {
        const int i = (tid >> 3) + 64 * k;
        *(LAS u32x4*)(lds + i * 128 + ((ch ^ ((i >> 1) & 7)) << 4)) = kreg[k];
        *(LAS u32x4*)(lds + 49152 + i * 128 + ((ch ^ (((i >> 1) & 1) << 2)) << 4)) = vreg[k];
    }
}
__device__ __forceinline__ int crow(int r, int hi) { return (r & 3) + 8 * (r >> 2) + 4 * hi; }
__device__ __forceinline__ void attn_compute(const Params& p, int u, int tid, LAS unsigned char* lds, const bf16x8 (&qf)[4]) {
    const int lane = tid & 63, wave = __builtin_amdgcn_readfirstlane(tid >> 6);
    const AttnGeom G = attn_geom(u);
    const int c = G.c;
    bf16_t* Og = (bf16_t*)(p.ws + WS_OG) + G.base; float* Lg = (float*)(p.ws + WS_LSE) + G.lbase;
    LAS unsigned char* ldsK = lds; LAS unsigned char* ldsV = lds + 49152;
    const int qi = lane & 31, hi = lane >> 5;
    const size_t posq = (size_t)(G.r + G.dil * (256 * c + 32 * wave + qi));
    f32x16 o0, o1;
#pragma unroll
    for (int e = 0; e < 16; ++e) { o0[e] = 0.f; o1[e] = 0.f; }
    float mrun = -1e30f, lrun = 0.f;
    const int jstart = (c == 0 && wave < 4) ? 4 - wave : 0;
    for (int jt = jstart; jt < 5; ++jt) {
        const int rowb = 32 * (wave + jt), krow = rowb + qi;
        f32x16 s;
#pragma unroll
        for (int e = 0; e < 16; ++e) s[e] = 0.f;
#pragma unroll
        for (int d0 = 0; d0 < 4; ++d0) { const int ch = 2 * d0 + hi;
            const bf16x8 kf = *(const LAS bf16x8*)(ldsK + krow * 128 + ((ch ^ ((krow >> 1) & 7)) << 4));
            s = __builtin_amdgcn_mfma_f32_32x32x16_bf16(kf, qf[d0], s, 0, 0, 0); }
        if (jt == 0) {
#pragma unroll
            for (int e = 0; e < 16; ++e) if (crow(e, hi) < qi) s[e] = -1e30f;
        }
        if (jt == 4) {
#pragma unroll
            for (int e = 0; e < 16; ++e) if (crow(e, hi) > qi) s[e] = -1e30f;
        }
        float mx = s[0];
#pragma unroll
        for (int e = 1; e < 16; ++e) mx = fmaxf(mx, s[e]);
        mx = fmaxf(mx, __shfl_xor(mx, 32));
        const float mnew = fmaxf(mrun, mx), alpha = __builtin_amdgcn_exp2f(mrun - mnew);
        float ls = 0.f;
#pragma unroll
        for (int e = 0; e < 16; ++e) { s[e] = __builtin_amdgcn_exp2f(s[e] - mnew); ls += s[e]; }
        lrun = lrun * alpha + ls; mrun = mnew;
#pragma unroll
        for (int e = 0; e < 16; ++e) { o0[e] *= alpha; o1[e] *= alpha; }
#pragma unroll
        for (int ks = 0; ks < 2; ++ks) {
            u32x4 pw; pw.x = pk_bf16(s[8 * ks + 0], s[8 * ks + 1]); pw.y = pk_bf16(s[8 * ks + 2], s[8 * ks + 3]); pw.z = pk_bf16(s[8 * ks + 4], s[8 * ks + 5]); pw.w = pk_bf16(s[8 * ks + 6], s[8 * ks + 7]);
            const bf16x8 pf = __builtin_bit_cast(bf16x8, pw);
            const int vrow = rowb + 16 * ks + 4 * hi + ((lane & 15) >> 2);
#pragma unroll
            for (int d0 = 0; d0 < 2; ++d0) {
                const int chv = 4 * d0 + 2 * ((lane >> 4) & 1) + ((lane & 3) >> 1);
                LAS unsigned char* a1 = ldsV + vrow * 128 + ((chv ^ (((vrow >> 1) & 1) << 2)) << 4) + 8 * (lane & 1);
                const s16x4 lo = __builtin_bit_cast(s16x4, __builtin_amdgcn_ds_read_tr16_b64_v4i16((LAS s16x4*)a1));
                const s16x4 hi4 = __builtin_bit_cast(s16x4, __builtin_amdgcn_ds_read_tr16_b64_v4i16((LAS s16x4*)(a1 + 8 * 128)));
                const bf16x8 vf = {lo[0], lo[1], lo[2], lo[3], hi4[0], hi4[1], hi4[2], hi4[3]};
                if (d0 == 0) o0 = __builtin_amdgcn_mfma_f32_32x32x16_bf16(vf, pf, o0, 0, 0, 0);
                else o1 = __builtin_amdgcn_mfma_f32_32x32x16_bf16(vf, pf, o1, 0, 0, 0);
            }
        }
    }
    lrun += __shfl_xor(lrun, 32);
    const float inv = 1.0f / lrun;
    LAS unsigned char* stg = lds + 98304 + wave * 4096;
#pragma unroll
    for (int a = 0; a < 4; ++a) {
        u32x2 w0, w1;
        w0.x = pk_bf16(o0[4 * a] * inv, o0[4 * a + 1] * inv); w0.y = pk_bf16(o0[4 * a + 2] * inv, o0[4 * a + 3] * inv);
        w1.x = pk_bf16(o1[4 * a] * inv, o1[4 * a + 1] * inv); w1.y = pk_bf16(o1[4 * a + 2] * inv, o1[4 * a + 3] * inv);
        *(LAS u32x2*)(stg + qi * 128 + (((a) ^ (qi & 7)) << 4) + 8 * hi) = w0;
        *(LAS u32x2*)(stg + qi * 128 + (((4 + a) ^ (qi & 7)) << 4) + 8 * hi) = w1;
    }
    asm volatile("s_waitcnt lgkmcnt(0)" ::: "memory");
#pragma unroll
    for (int i = 0; i < 4; ++i) {
        const int row = i * 8 + (lane >> 3), ch = lane & 7;
        const u32x4 v = *(const LAS u32x4*)(stg + row * 128 + ((ch ^ (row & 7)) << 4));
        const size_t pr = (size_t)(G.r + G.dil * (256 * c + 32 * wave + row));
        *(u32x4*)(Og + pr * DM + ch * 8) = v;
    }
    if (hi == 0) Lg[posq * 16] = mrun + __builtin_amdgcn_logf(lrun);
}

__device__ __forceinline__ f32x4 bf4_to_f32(u32x2 w) { f32x4 r; r[0] = __uint_as_float(w.x << 16); r[1] = __uint_as_float(w.x & 0xffff0000u); r[2] = __uint_as_float(w.y << 16); r[3] = __uint_as_float(w.y & 0xffff0000u); return r; }
struct SampState { float m, l; f32x4 o; };
__device__ __forceinline__ void sample_load(const Params& p, int u, int bi, int tid, u32x2 (&kk)[11], u32x2 (&vv)[11], f32x4& q4) {
    const int lane = tid & 63, t = tid >> 6, n = u >> 4, h = u & 15, kq = lane >> 4, dq = lane & 15, g = bi / 3, ci = bi - 3 * g;
    const int hist = 128 << (2 * g), dil = 1 << (2 * g);
    const bf16_t* CK = (const bf16_t*)(p.ws + WS_CK); const bf16_t* CV = (const bf16_t*)(p.ws + WS_CV);
    const size_t cb = pg8::ckv_off(g, n, h, 0) + 4 * dq;
    q4 = *(const f32x4*)((const float*)(p.ws + WS_QS) + (size_t)(n * 8 + t) * 3072 + (g * 16 + h) * 64 + 4 * dq);
#pragma unroll
    for (int i = 0; i < 11; ++i) {
        const int j = 4 * (11 * ci + i) + kq, jc = j <= 128 ? j : 128;
        const int idxc = g == 2 ? (128 - jc) * 8 + t : hist + t - dil * jc;
        kk[i] = *(const u32x2*)(CK + cb + (size_t)idxc * 64); vv[i] = *(const u32x2*)(CV + cb + (size_t)idxc * 64);
    }
}
__device__ __forceinline__ void sample_math(int bi, int tid, const u32x2 (&kk)[11], const u32x2 (&vv)[11], const f32x4 q4, SampState& S) {
    const int kq = (tid & 63) >> 4, ci = bi % 3;
    float m = S.m, l = S.l; f32x4 o = S.o;
#pragma unroll
    for (int i = 0; i < 11; ++i) {
        const int j = 4 * (11 * ci + i) + kq;
        const f32x4 k4 = bf4_to_f32(kk[i]), v4 = bf4_to_f32(vv[i]);
        float s = (q4[0] * k4[0] + q4[1] * k4[1]) + (q4[2] * k4[2] + q4[3] * k4[3]);
        s += __shfl_xor(s, 1); s += __shfl_xor(s, 2); s += __shfl_xor(s, 4); s += __shfl_xor(s, 8);
        if (j > 128) s = -1e30f;
        const float mnew = fmaxf(m, s), alpha = __builtin_amdgcn_exp2f(m - mnew), pp = __builtin_amdgcn_exp2f(s - mnew);
        l = l * alpha + pp; o = o * alpha + v4 * pp; m = mnew;
    }
    S.m = m; S.l = l; S.o = o;
}
__device__ __forceinline__ void sample_finish(const Params& p, int u, int tid, SampState& S) {
    const int lane = tid & 63, t = tid >> 6, n = u >> 4, h = u & 15, kq = lane >> 4, dq = lane & 15;
    float m = S.m, l = S.l; f32x4 o = S.o;
    float M = fmaxf(m, __shfl_xor(m, 16)); M = fmaxf(M, __shfl_xor(M, 32));
    const float f = __builtin_amdgcn_exp2f(m - M); l *= f; o = o * f;
    l += __shfl_xor(l, 16); l += __shfl_xor(l, 32);
#pragma unroll
    for (int e = 0; e < 4; ++e) { float x = o[e]; x += __shfl_xor(x, 16); x += __shfl_xor(x, 32); o[e] = x; }
    if (kq == 0) { const float inv = 1.0f / l; u32x2 w; w.x = pk_bf16(o[0] * inv, o[1] * inv); w.y = pk_bf16(o[2] * inv, o[3] * inv);
        *(u32x2*)((bf16_t*)(p.ws + WS_OB) + (size_t)(MP + n * 8 + t) * DM + h * 64 + 4 * dq) = w; }
    S.m = -1e30f; S.l = 0.f; S.o = (f32x4){0.f, 0.f, 0.f, 0.f};
}
__device__ __forceinline__ void phase_attn(const Params& p, LAS unsigned char* lds, int dup) {
    const int tid = opaque_tid();
    int su = blockIdx.x, sb = 0;
    SampState S; S.m = -1e30f; S.l = 0.f; S.o = (f32x4){0.f, 0.f, 0.f, 0.f};
    int u = blockIdx.x;
    u32x4 kreg[6], vreg[6]; bf16x8 qf[4];
    if (u < 3072) { attn_load(p, u, tid, kreg, vreg); attn_load_q(p, u, tid, qf); }
    for (; u < 3072; u += gridDim.x) {
        attn_stage(tid, lds, kreg, vreg);
        __syncthreads();
        const bool hs = su < 512;
        u32x2 kk[11], vv[11]; f32x4 q4;
        if (hs) sample_load(p, su, sb, tid, kk, vv, q4);
        const int un = u + gridDim.x;
        if (un < 3072) attn_load(p, un, tid, kreg, vreg);
        attn_compute(p, u, tid, lds, qf);
        if (un < 3072) attn_load_q(p, un, tid, qf);
        if (hs) { sample_math(sb, tid, kk, vv, q4, S); if (++sb == 9) { sample_finish(p, su, tid, S); sb = 0; su += gridDim.x; } }
        __syncthreads();
    }
    if (su < 512) {
        u32x2 ka[11], va[11], kb[11], vb[11]; f32x4 qa, qb;
        sample_load(p, su, sb, tid, ka, va, qa);
        for (;;) {
            int su2 = su, sb2 = sb + 1; if (sb2 == 9) { sb2 = 0; su2 += gridDim.x; }
            const bool more = su2 < 512;
            if (more) sample_load(p, su2, sb2, tid, kb, vb, qb);
            sample_math(sb, tid, ka, va, qa, S); if (sb == 8) sample_finish(p, su, tid, S);
            if (!more) break;
            su = su2; sb = sb2;
            su2 = su; sb2 = sb + 1; if (sb2 == 9) { sb2 = 0; su2 += gridDim.x; }
            const bool more2 = su2 < 512;
            if (more2) sample_load(p, su2, sb2, tid, ka, va, qa);
            sample_math(sb, tid, kb, vb, qb, S); if (sb == 8) sample_finish(p, su, tid, S);
            if (!more2) break;
            su = su2; sb = sb2;
        }
    }
}

constexpr int NTASK_A = 32 * (16 + 64 + 128), NTASK = NTASK_A + 32 * 128;
struct ChunkGeom { int g, n, R0, hist; };
__device__ __forceinline__ ChunkGeom chunk_geom(int it) {
    ChunkGeom C; int ck;
    if (it < 32 * 16) { C.g = 0; C.n = it >> 4; ck = it & 15; }
    else if (it < 32 * (16 + 64)) { const int r = it - 32 * 16; C.g = 1; C.n = r >> 6; ck = r & 63; }
    else if (it < NTASK_A) { const int r = it - 32 * (16 + 64); C.g = 2; C.n = r >> 7; ck = 2 * (r & 127); }
    else { const int r = it - NTASK_A; C.g = 2; C.n = r >> 7; ck = 2 * (r & 127) + 1; }
    C.hist = 128 << (2 * C.g); C.R0 = 8 * ck; return C;
}
__device__ __forceinline__ void chunk_load(const Params& p, int it, int tid, f32x4 (&v)[8]) {
    const ChunkGeom C = chunk_geom(it);
    const float* cache = C.g == 0 ? p.cache0 : (C.g == 1 ? p.cache1 : p.cache2);
    const f32x4* src = (const f32x4*)(cache + ((size_t)C.n * C.hist + C.R0) * 2048) + tid;
#pragma unroll
    for (int k = 0; k < 8; ++k) v[k] = __builtin_nontemporal_load(src + k * 512);
}
__device__ __forceinline__ void chunk_store(const Params& p, int it, int tid, const f32x4 (&v)[8]) {
    const ChunkGeom C = chunk_geom(it);
    if (C.R0 >= 8) {
        f32x4* dst = (f32x4*)(p.out + (C.g == 0 ? O_KS0 : (C.g == 1 ? O_KS1 : O_KS2)) + ((size_t)C.n * C.hist + C.R0 - 8) * 2048) + tid;
#pragma unroll
        for (int k = 0; k < 8; ++k) __builtin_nontemporal_store(v[k], dst + k * 512);
    }
    if (it < NTASK_A) {
        const int kv = tid >> 8, h = (tid >> 4) & 15, d4 = tid & 15;
        const int idxc0 = C.g == 2 ? (C.R0 >> 4) * 8 : C.R0;
        bf16_t* cp = (bf16_t*)(p.ws + (kv ? WS_CV : WS_CK)) + pg8::ckv_off(C.g, C.n, h, idxc0) + 4 * d4;
#pragma unroll
        for (int k = 0; k < 8; ++k) { u32x2 w; w.x = pk_bf16(v[k][0], v[k][1]); w.y = pk_bf16(v[k][2], v[k][3]); *(u32x2*)(cp + k * 64) = w; }
    }
}
__device__ __forceinline__ void steal_work(const Params& p, LAS unsigned char* lds, int k, unsigned mand) {
    unsigned* ctl = (unsigned*)(p.ws + WS_CTL);
    const int tid = opaque_tid();
    LAS int* flag = (LAS int*)lds;
    __syncthreads();
    if (k >= 0 && tid == 0) atomicAdd(ctl + 64 + 16 * k, 1u);
    for (;;) {
        if (tid == 0) {
            int t0 = -1, t1 = -1; bool go = true, forced = k < 0;
            if (k >= 0) go = __hip_atomic_load(ctl + 64 + 16 * k, __ATOMIC_RELAXED, __HIP_MEMORY_SCOPE_AGENT) < gridDim.x;
            if (!go && mand) { go = __hip_atomic_load(ctl, __ATOMIC_RELAXED, __HIP_MEMORY_SCOPE_AGENT) < mand; forced = go; }
            if (go) { const unsigned nt = forced ? 2u : 1u; const unsigned tk = atomicAdd(ctl, nt); if (tk < (unsigned)NTASK) t0 = (int)tk; if (nt == 2u && tk + 1u < (unsigned)NTASK) t1 = (int)(tk + 1u); }
            flag[0] = t0; flag[1] = t1;
        }
        __syncthreads();
        const int t0 = flag[0], t1 = flag[1];
        __syncthreads();
        if (t0 < 0) break;
        f32x4 va[8];
        chunk_load(p, t0, tid, va);
        if (t1 >= 0) { f32x4 vb[8]; chunk_load(p, t1, tid, vb); chunk_store(p, t0, tid, va); chunk_store(p, t1, tid, vb); }
        else chunk_store(p, t0, tid, va);
    }
}

#define XB_TMO      128
#define XB_XCNT(j)  (256  + 64 * (j))
#define XB_XSUB(j)  (1280 + 64 * (j))
#define XB_XGEN(j)  (2304 + 64 * (j))
#define XB_TOP      3328
#define XB_TOPGEN   3392
#define XCD_BAR_WORDS 3456
#define XB_SPIN_CAP (1u << 18)

__device__ __forceinline__ unsigned xb_ld(unsigned* p)              { return __hip_atomic_load(p, __ATOMIC_RELAXED, __HIP_MEMORY_SCOPE_AGENT); }
__device__ __forceinline__ unsigned xb_add(unsigned* p, unsigned v) { return __hip_atomic_fetch_add(p, v, __ATOMIC_RELAXED, __HIP_MEMORY_SCOPE_AGENT); }
__device__ __forceinline__ unsigned xb_xcc_id() { return (unsigned)__builtin_amdgcn_s_getreg((3 << 11) | 20) & 0xFu; }
#define XB_SPIN(cond, bar) do { unsigned _sp = 0; while (cond) { __builtin_amdgcn_s_sleep(1); \
    if ((++_sp & 255u) == 0u) { if (xb_ld(&(bar)[XB_TMO])) break; if (_sp > XB_SPIN_CAP) { atomicAdd(&(bar)[XB_TMO], 1u); break; } } } } while (0)

struct XcdBarrier {
    unsigned* bar; unsigned x;
    volatile LAS unsigned* st;
};

__device__ __forceinline__ XcdBarrier xcd_barrier_post(unsigned* bar, volatile LAS unsigned* st) {
    XcdBarrier b; b.bar = bar; b.x = xb_xcc_id(); b.st = st;
    if (threadIdx.x == 0) (void)xb_add(&bar[XB_XCNT(b.x)], 1u);
    return b;
}
__device__ __forceinline__ void xcd_barrier_complete(unsigned* bar, unsigned x, unsigned& nloc, unsigned& nx) {
    const unsigned G = gridDim.x * gridDim.y * gridDim.z;
    unsigned sum, cnt, mine, sp = 0u;
    for (;;) {
        sum = 0u; cnt = 0u; mine = 0u;
#pragma unroll
        for (unsigned j = 0; j < 16; ++j) { const unsigned c = xb_ld(&bar[XB_XCNT(j)]); sum += c; cnt += (c > 0u) ? 1u : 0u; mine = (j == x) ? c : mine; }
        if (sum == G) break;
        __builtin_amdgcn_s_sleep(1);
        if ((++sp & 255u) == 0u) { if (xb_ld(&bar[XB_TMO])) break; if (sp > XB_SPIN_CAP) { atomicAdd(&bar[XB_TMO], 1u); break; } }
    }
    nloc = mine > 0u ? mine : 1u; nx = cnt > 0u ? cnt : 1u;
}

__device__ __forceinline__ void xcd_barrier(const XcdBarrier& b) {
    asm volatile("s_waitcnt vmcnt(0)" ::: "memory");
    __syncthreads();
    if (threadIdx.x == 0) {
        unsigned* bar = b.bar;
        __builtin_amdgcn_s_waitcnt(0);
        unsigned nloc = b.st[0], nx = b.st[1];
        if (nloc == 0u) { xcd_barrier_complete(bar, b.x, nloc, nx); b.st[0] = nloc; b.st[1] = nx; }
        const unsigned old = xb_add(&bar[XB_XSUB(b.x)], 1u);
        const unsigned gen = old / nloc;
        if (old + 1u == (gen + 1u) * nloc) {
            __builtin_amdgcn_fence(__ATOMIC_RELEASE, "agent");
            asm volatile("s_waitcnt vmcnt(0)" ::: "memory");
            const unsigned og = xb_add(&bar[XB_TOP], 1u);
            const unsigned tg = og / nx;
            if (og + 1u == (tg + 1u) * nx) xb_add(&bar[XB_TOPGEN], 1u);
            else XB_SPIN(xb_ld(&bar[XB_TOPGEN]) == tg, bar);
            __builtin_amdgcn_fence(__ATOMIC_ACQUIRE, "agent");
            xb_add(&bar[XB_XGEN(b.x)], 1u);
            asm volatile("s_waitcnt vmcnt(0)" ::: "memory");
        } else {
            XB_SPIN(xb_ld(&bar[XB_XGEN(b.x)]) == gen, bar);
            __builtin_amdgcn_fence(__ATOMIC_ACQUIRE, "agent");
            asm volatile("s_waitcnt vmcnt(0)" ::: "memory");
        }
    }
    __syncthreads();
}

__device__ __forceinline__ void seam_barrier(const Params& p, int k) {
    unsigned* w = (unsigned*)(p.ws + WS_CTL) + 3072 + 16 * k;
    __syncthreads();
    if (opaque_tid() == 0) {
        __builtin_amdgcn_fence(__ATOMIC_RELEASE, "agent");
        asm volatile("s_waitcnt vmcnt(0)" ::: "memory");
        __hip_atomic_fetch_add(w, 1u, __ATOMIC_RELAXED, __HIP_MEMORY_SCOPE_AGENT);
        unsigned spins = 0;
        while (__hip_atomic_load(w, __ATOMIC_RELAXED, __HIP_MEMORY_SCOPE_AGENT) < gridDim.x) { __builtin_amdgcn_s_sleep(1); if (++spins > (1u << 24)) break; }
        __builtin_amdgcn_fence(__ATOMIC_ACQUIRE, "agent");
        asm volatile("s_waitcnt vmcnt(0)" ::: "memory");
    }
    __syncthreads();
}

constexpr int NSTEPS = 20;
#ifndef PROBE_DUP_MASK
#define PROBE_DUP_MASK 0u
#endif
__global__ void __launch_bounds__(NTHREADS, 2) yoco_fwd(Params p) {
    extern __shared__ __attribute__((aligned(16))) unsigned char lds_raw[];
    LAS unsigned char* lds = (LAS unsigned char*)lds_raw;
    cg::grid_group grid = cg::this_grid();
    volatile LAS unsigned* xst = (volatile LAS unsigned*)(lds + 131072 + 64);
    if (threadIdx.x == 0) { xst[0] = 0u; xst[1] = 0u; }
    __syncthreads();
    const XcdBarrier xbar = xcd_barrier_post((unsigned*)(p.ws + WS_CTL) + 4096, xst);
    grid.sync();
    unsigned char* ws = p.ws;
    float* X = p.out + O_YP;
    bf16_t* XB = (bf16_t*)(ws + WS_XB); bf16_t* H = (bf16_t*)(ws + WS_H); float* SSQ = (float*)(ws + WS_SSQ);
    const float* ropec = (const float*)(ws + WS_ROPE); const float* ropes = ropec + 4104 * 32;
    const int G = gridDim.x, c = blockIdx.x;
#pragma unroll 1
    for (int st2 = 2 * p.lo; st2 < 2 * p.hi; ++st2) {
        const int st = st2 >> 1;
        if ((st2 & 1) && !((PROBE_DUP_MASK >> st) & 1u)) continue;
        int kind, layer = 0, ssq_in = 0, ssq_out = -1;
        switch (st) {
            case 0: kind = 0; break;
            case 1: kind = 1; layer = 0; ssq_out = 0; break;
            case 2: kind = 2; layer = 0; ssq_in = 0; break;
            case 3: kind = 3; layer = 0; break;
            case 4: kind = 4; break;
            case 5: kind = 1; layer = 1; ssq_out = 1; break;
            case 6: kind = 2; layer = 1; ssq_in = 1; break;
            case 7: kind = 3; layer = 1; ssq_out = 2; break;
            case 8: kind = 5; ssq_in = 2; break;
            case 9: kind = 6; break;
            case 10: kind = 7; break;
            case 11: kind = 8; layer = 0; ssq_out = 3; break;
            case 12: kind = 2; layer = 2; ssq_in = 3; break;
            case 13: kind = 3; layer = 2; ssq_out = 4; break;
            case 14: kind = 9; ssq_in = 4; break;
            case 15: kind = 6; break;
            case 16: kind = 7; break;
            case 17: kind = 8; layer = 1; ssq_out = 5; break;
            case 18: kind = 2; layer = 3; ssq_in = 5; break;
            default: kind = 3; layer = 3; break;
        }
#ifdef PROBE_EMPTY_DUP
        if (st2 & 1) kind = -1;
#endif
        if (kind < 0) {}
        else if (kind == 0) phase_prep(p, lds);
        else if (kind == 4) pool_prep(p, 1, lds);
        else if (kind == 6) phase_attn(p, lds, st2 & 1);
        else if (kind == 7) {
            if (c < G - 4) phase_merge(p, c, G - 4);
            else {
                const int j = st == 10 ? 0 : 1, so = j == 0 ? 3 : 5;
                pg8::Gemm g{(const bf16_t*)(ws + WS_OB), (const bf16_t*)(ws + WS_WO) + (size_t)j * DM * DM, MT, DM, DM};
                pg8::StaticOrder S; S.init(MP, DM, G, c - (G - 4), 4);
                pg8::EpiResid E; E.X = X; E.scale = nullptr; E.xin_p = X; E.xin_s = X + (size_t)MP * DM; E.xb = XB; E.ssq = SSQ + (size_t)so * MT;
                pg8::gemm_phase<pg8::EpiResid, pg8::StaticOrder, true, true>(lds, g, S, E);
            }
        }
        else if (kind == 2) {
            unsigned* scnt = (unsigned*)(ws + WS_CTL) + 2048 + 16 * layer;
            if (c < G - 8) {
                pg8::Gemm g{XB, (const bf16_t*)(ws + WS_WGU) + (size_t)layer * 2 * FF * DM, MT, 2 * FF, DM};
                pg8::StaticOrder S; S.init(MP, 2 * FF, G - 8, c, 3); S.cnt = scnt;
                pg8::EpiGU E{SSQ + (size_t)ssq_in * MT, H};
                pg8::gemm_phase<pg8::EpiGU, pg8::StaticOrder, true, true>(lds, g, S, E);
            } else if (c < G - 4) {
                if (opaque_tid() == 0) { while (__hip_atomic_load(scnt, __ATOMIC_RELAXED, __HIP_MEMORY_SCOPE_AGENT) < 22u) __builtin_amdgcn_s_sleep(32); }
                __syncthreads();
                __builtin_amdgcn_fence(__ATOMIC_ACQUIRE, "agent");
                const int so = layer == 1 ? 2 : (layer == 2 ? 4 : -1);
                pg8::Gemm g{H, (const bf16_t*)(ws + WS_WDN) + (size_t)layer * DM * FF, MT, DM, FF};
                pg8::StaticOrder S; S.init(MP, DM, G, c - (G - 8), 4);
                pg8::EpiResid E; E.X = X; E.scale = nullptr; E.xin_p = X; E.xin_s = X + (size_t)MP * DM;
                E.xb = so >= 0 ? XB : nullptr; E.ssq = so >= 0 ? SSQ + (size_t)so * MT : nullptr;
                pg8::gemm_phase<pg8::EpiResid, pg8::StaticOrder, true, true>(lds, g, S, E);
            }
        } else if (kind == 5 || kind == 9) {
            pg8::Gemm g{XB, (const bf16_t*)(ws + (kind == 5 ? WS_WKVQ : WS_WQ1)), MT, kind == 5 ? 9216 : 3072, DM};
            pg8::StaticOrder S; S.init(MT, g.N, G, c, 0);
            pg8::EpiQKV E{SSQ + (size_t)ssq_in * MT, kind == 5 ? 0 : 24, p.k_norm, p.q_norm + (kind == 5 ? 0 : 192), ropec, ropes,
                          (bf16_t*)(ws + WS_KB), (bf16_t*)(ws + WS_VB), (bf16_t*)(ws + WS_QB), (float*)(ws + WS_QS), p.out, (bf16_t*)(ws + WS_CK), (bf16_t*)(ws + WS_CV)};
            pg8::gemm_phase<pg8::EpiQKV, pg8::StaticOrder, true, true>(lds, g, S, E);
        } else {
            pg8::Gemm g; pg8::StaticOrder S; pg8::EpiResid E;
            E.X = X; E.scale = nullptr; E.xin_p = X; E.xin_s = X + (size_t)MP * DM;
            E.xb = ssq_out >= 0 ? XB : nullptr; E.ssq = ssq_out >= 0 ? SSQ + (size_t)ssq_out * MT : nullptr;
            if (kind == 1) {
                g = pg8::Gemm{(const bf16_t*)(ws + WS_DBUF), (const bf16_t*)(ws + WS_WPOOL) + (size_t)layer * 4 * 65536, 4 * MT, 1024, 256};
                S.init(MT, 1024, G, c, 1); E.scale = p.pool_scale + layer * DM;
                if (layer == 0) { E.xin_p = p.x_prompt; E.xin_s = p.x_sample; }
            } else if (kind == 3) {
                g = pg8::Gemm{H, (const bf16_t*)(ws + WS_WDN) + (size_t)layer * DM * FF, MP, DM, FF};
                S.init(MP, DM, G, c, 0);
            } else {
                g = pg8::Gemm{(const bf16_t*)(ws + WS_OB), (const bf16_t*)(ws + WS_WO) + (size_t)layer * DM * DM, MP, DM, DM};
                S.init(MP, DM, G, c, 0);
            }
            pg8::gemm_phase<pg8::EpiResid, pg8::StaticOrder, true, true>(lds, g, S, E);
        }
        if (st2 + 2 < 2 * p.hi) {
            if (kind == 1 || kind == 2 || kind == 5 || kind == 9) steal_work(p, lds, st2, st == 8 ? (unsigned)NTASK_A : 0u);
            xcd_barrier(xbar);
        }
    }
    steal_work(p, lds, -1, 0u);
}

extern "C" void kernel_launch(void* const* d_in, const int* in_sizes, int n_in, void* d_out, int out_size, void* d_ws, size_t ws_size, hipStream_t stream) {
    static int grid = 0;
    if (grid == 0) {
        if (n_in != 20 || (size_t)out_size != O_END || ws_size < WS_END) { fprintf(stderr, "kernel_launch: unexpected shapes: n_in %d out %d ws %zu (need %zu)\n", n_in, out_size, ws_size, (size_t)WS_END); grid = -1; return; }
        int dev = 0, cus = 0, per_cu = 0;
        hipGetDevice(&dev); hipDeviceGetAttribute(&cus, hipDeviceAttributeMultiprocessorCount, dev);
        if (hipFuncSetAttribute((const void*)yoco_fwd, hipFuncAttributeMaxDynamicSharedMemorySize, LDS_BYTES) != hipSuccess) { fprintf(stderr, "kernel_launch: hipFuncSetAttribute failed\n"); grid = -1; return; }
        if (hipOccupancyMaxActiveBlocksPerMultiprocessor(&per_cu, (const void*)yoco_fwd, NTHREADS, LDS_BYTES) != hipSuccess || per_cu < 1) { fprintf(stderr, "kernel_launch: occupancy query failed (%d)\n", per_cu); (void)hipGetLastError(); per_cu = 1; }
        grid = cus * per_cu;
    }
    if (grid < 0) return;
    Params p{};
    const float** pp = (const float**)&p;
    for (int i = 0; i < 20; ++i) pp[i] = (const float*)d_in[i];
    p.out = (float*)d_out; p.ws = (unsigned char*)d_ws; p.lo = 0; p.hi = NSTEPS;
    if (hipMemsetAsync((unsigned char*)d_ws + WS_CTL, 0, 32768, stream) != hipSuccess) { fprintf(stderr, "kernel_launch: memset failed\n"); return; }
    void* args[] = {&p};
    hipError_t e = hipLaunchCooperativeKernel((const void*)yoco_fwd, dim3(grid), dim3(NTHREADS), args, LDS_BYTES, stream);
    if (e != hipSuccess) fprintf(stderr, "kernel_launch: cooperative launch failed: %s (grid %d)\n", hipGetErrorString(e), grid);
}
```
